# Optimizing an MI355X kernel written in HIP

```python
import math
import jax, jax.numpy as jnp
from jax import lax
import numpy as np

D_MODEL = 1024
BATCH = 4
SEQ = 4096
DEPTH = 1

CTX_LEN = 256
GRID_W = 64
D_MIX = D_MODEL
D_LRU = D_MIX // 2
LRU_BLOCKS = 8
LRU_BLOCK_W = D_LRU // LRU_BLOCKS
CONV_W = 4
LRU_C = 8.0
GLA_HEADS = 4
D_GLA_V = D_MIX - D_LRU
D_GLA_K = D_GLA_V // 2
GLA_DK = D_GLA_K // GLA_HEADS
GLA_DV = D_GLA_V // GLA_HEADS
GATE_RANK = 16
GATE_TAU = 16.0
GLA_CHUNK = 64
N_EXPERTS = 32
TOP_K = 4
D_EXPERT = D_MODEL
SWIGLU_LIMIT = 7.0
SWIGLU_ALPHA = 1.702
MOE_BLOCK = 128
N_MOD = 6
DEEPNORM_ALPHA = (2.0 * DEPTH) ** 0.25
DEEPNORM_BETA = (8.0 * DEPTH) ** -0.25
LN_EPS = 1e-5
RMS_EPS = 1e-6
SPLIT_SIZES = (D_LRU, D_LRU, D_GLA_K, D_GLA_K, D_GLA_V, D_GLA_V, GATE_RANK)
D_IN = sum(SPLIT_SIZES)
SPLIT_POINTS = tuple(sum(SPLIT_SIZES[:i + 1]) for i in range(len(SPLIT_SIZES) - 1))

kernel_name = "hymba_rglru_gla_moe_dit_layer"

f32 = jnp.float32


def layer_norm(x, g, b):
    xf = x.astype(f32)
    mu = xf.mean(-1, keepdims=True)
    var = jnp.square(xf - mu).mean(-1, keepdims=True)
    return ((xf - mu) * lax.rsqrt(var + LN_EPS) * g.astype(f32) + b.astype(f32)).astype(x.dtype)


def ada_mod(cvec, w, b):
    m = jax.nn.silu(cvec) @ w + b
    return jnp.split(m[..., None, :], N_MOD, axis=-1)


def modulate(x, shift, scale):
    return x * (1.0 + scale) + shift


def centred_dwconv(u, w, b):
    pad_l = CONV_W // 2
    pad_r = CONV_W - 1 - pad_l
    L = u.shape[-2]
    up = jnp.pad(u, [(0, 0)] * (u.ndim - 2) + [(pad_l, pad_r), (0, 0)])
    out = b
    for tap in range(CONV_W):
        out = out + up[..., tap:tap + L, :] * w[tap]
    return out


def to_col_major(t, rows):
    B_, L, C = t.shape
    return t.reshape(B_, rows, GRID_W, C).transpose(0, 2, 1, 3).reshape(B_, L, C)


def from_col_major(t, rows):
    B_, L, C = t.shape
    return t.reshape(B_, GRID_W, rows, C).transpose(0, 2, 1, 3).reshape(B_, L, C)


def _linear_combine(left, right):
    a_l, b_l = left
    a_r, b_r = right
    return a_l * a_r, a_r * b_l + b_r


def rglru_scan(u, h0, w_a, b_a, w_x, b_x, lam):
    B_, L, _ = u.shape
    ub = u.reshape(B_, L, LRU_BLOCKS, LRU_BLOCK_W)
    r = jax.nn.sigmoid(jnp.einsum('blnc,ncd->blnd', ub, w_a).reshape(B_, L, D_LRU) + b_a)
    i = jax.nn.sigmoid(jnp.einsum('blnc,ncd->blnd', ub, w_x).reshape(B_, L, D_LRU) + b_x)
    log_a = (-LRU_C * jax.nn.softplus(-lam.astype(f32))) * r.astype(f32)
    a = jnp.exp(log_a)
    b = jnp.sqrt(-jnp.expm1(2.0 * log_a)) * (i * u).astype(f32)
    b = b.at[:, 0].add(a[:, 0] * h0)
    _, h = lax.associative_scan(_linear_combine, (a, b), axis=1)
    return h


def gla_chunked(q, k, v, log_alpha, s0):
    B_, H, L, _ = q.shape
    n = L // GLA_CHUNK

    def chunks(t):
        return t.astype(f32).reshape(B_, H, n, GLA_CHUNK, t.shape[-1])

    qc, kc, vc, lac = chunks(q), chunks(k), chunks(v), chunks(log_alpha)
    bcum = jnp.cumsum(lac, axis=-2)
    btot = bcum[..., -1:, :]
    q_dec = qc * jnp.exp(bcum)
    k_dec = kc * jnp.exp(-bcum)
    k_end = kc * jnp.exp(btot - bcum)
    mask = jnp.tril(jnp.ones((GLA_CHUNK, GLA_CHUNK), dtype=bool))
    scores = jnp.where(mask, jnp.einsum('bhnik,bhnjk->bhnij', q_dec, k_dec), 0.0)
    o_intra = jnp.einsum('bhnij,bhnjv->bhniv', scores, vc)
    chunk_kv = jnp.einsum('bhnjk,bhnjv->bhnkv', k_end, vc)
    decay_tot = jnp.exp(btot[..., 0, :])

    def step(s, inp):
        dec, kv = inp
        return dec[..., None] * s + kv, s

    s_final, s_starts = lax.scan(step, s0, (jnp.moveaxis(decay_tot, 2, 0), jnp.moveaxis(chunk_kv, 2, 0)))
    s_starts = jnp.moveaxis(s_starts, 0, 2)
    o_inter = jnp.einsum('bhnik,bhnkv->bhniv', q_dec, s_starts)
    o = (o_intra + o_inter).reshape(B_, H, L, GLA_DV)
    return o, s_final


def mix_stream(u, rows, lru_init, gla_init, w_in, conv_w, conv_b, lru_wa, lru_ba, lru_wx, lru_bx,
               lru_lam, gla_wa, gla_ba):
    B_, L, _ = u.shape
    proj = u @ w_in
    x_lru, gate_lru, q, k, v, g, a_low = jnp.split(proj, SPLIT_POINTS, axis=-1)
    if rows is None:
        x_lru = centred_dwconv(x_lru, conv_w, conv_b)
    else:
        x_lru = centred_dwconv(x_lru.reshape(B_, rows, GRID_W, D_LRU), conv_w, conv_b).reshape(B_, L, D_LRU)
        q, k, v, a_low = (to_col_major(t, rows) for t in (q, k, v, a_low))

    def heads(t):
        return t.reshape(B_, L, GLA_HEADS, -1).transpose(0, 2, 1, 3)

    qh = heads(q) * (GLA_DK ** -0.5)
    kh = heads(k)
    vh = heads(v)
    lru_states, gla_states, h_dirs, o_dirs = [], [], [], []
    for d in range(2):
        xs = x_lru if d == 0 else jnp.flip(x_lru, 1)
        h = rglru_scan(xs, lru_init[d], lru_wa[d], lru_ba[d], lru_wx[d], lru_bx[d], lru_lam[d])
        lru_states.append(h[:, -1])
        h_dirs.append(h if d == 0 else jnp.flip(h, 1))
        la = heads(jax.nn.log_sigmoid((a_low @ gla_wa[d] + gla_ba[d]).astype(f32)) / GATE_TAU)
        seqs = (qh, kh, vh, la) if d == 0 else tuple(jnp.flip(t, 2) for t in (qh, kh, vh, la))
        o, s = gla_chunked(*seqs, gla_init[d])
        gla_states.append(s)
        o_dirs.append(o if d == 0 else jnp.flip(o, 2))
    h_lru = h_dirs[0] + h_dirs[1]
    o_gla = (o_dirs[0] + o_dirs[1]).transpose(0, 2, 1, 3).reshape(B_, L, D_GLA_V)
    if rows is not None:
        o_gla = from_col_major(o_gla, rows)
    return (h_lru, gate_lru, o_gla, g), jnp.stack(lru_states), jnp.stack(gla_states)


def merge_heads(h_lru, gate_lru, o_gla, g, gla_norm_g, w_out):
    y_lru = h_lru * jax.nn.gelu(gate_lru.astype(f32))
    B_, L, _ = o_gla.shape
    oh = o_gla.reshape(B_, L, GLA_HEADS, GLA_DV)
    oh = oh * lax.rsqrt(jnp.mean(jnp.square(oh), -1, keepdims=True) + RMS_EPS)
    y_gla = oh.reshape(B_, L, D_GLA_V) * gla_norm_g.astype(f32) * jax.nn.silu(g.astype(f32))
    y = jnp.concatenate([y_lru, y_gla], axis=-1).astype(w_out.dtype)
    return y @ w_out


def moe_ffn(h, w_router, b_router, w_gate, b_gate, w_up, b_up, w_down, b_down):
    B_, L, D = h.shape
    xt = h.reshape(-1, D)
    T = xt.shape[0]
    logits = (xt @ w_router + b_router).astype(f32)
    top_v, top_i = lax.top_k(logits, TOP_K)
    top_w = jax.nn.softmax(top_v, axis=-1)
    n_assign = T * TOP_K
    expert_flat = top_i.reshape(-1)
    token_flat = jnp.arange(n_assign, dtype=jnp.int32) // TOP_K
    w_flat = top_w.reshape(-1)
    order = jnp.argsort(expert_flat)
    e_sorted = expert_flat[order]
    counts = jnp.bincount(expert_flat, length=N_EXPERTS)
    starts = jnp.cumsum(counts) - counts
    padded = (counts + MOE_BLOCK - 1) // MOE_BLOCK * MOE_BLOCK
    pad_ends = jnp.cumsum(padded)
    pad_starts = pad_ends - padded
    rank = jnp.arange(n_assign, dtype=jnp.int32) - starts[e_sorted]
    dest = pad_starts[e_sorted] + rank
    n_blocks = -(-(n_assign + N_EXPERTS * (MOE_BLOCK - 1)) // MOE_BLOCK)
    n_rows = n_blocks * MOE_BLOCK
    row_token = jnp.zeros((n_rows,), jnp.int32).at[dest].set(token_flat[order])
    row_weight = jnp.zeros((n_rows,), f32).at[dest].set(w_flat[order])
    block_expert = jnp.minimum(
        jnp.searchsorted(pad_ends, jnp.arange(n_blocks, dtype=jnp.int32) * MOE_BLOCK, side='right'),
        N_EXPERTS - 1)

    def expert_block(args):
        tok, e = args
        xb = xt[tok]
        gate = jnp.minimum(xb @ w_gate[e] + b_gate[e], SWIGLU_LIMIT)
        up = jnp.clip(xb @ w_up[e] + b_up[e], -SWIGLU_LIMIT, SWIGLU_LIMIT)
        act = (up + 1.0) * gate * jax.nn.sigmoid(SWIGLU_ALPHA * gate)
        return act @ w_down[e] + b_down[e]

    y_rows = lax.map(expert_block, (row_token.reshape(n_blocks, MOE_BLOCK), block_expert))
    y_rows = y_rows.reshape(n_rows, D) * row_weight[:, None].astype(y_rows.dtype)
    y = jnp.zeros_like(xt).at[row_token].add(y_rows.astype(xt.dtype))
    return y.reshape(B_, L, D)


def setup_inputs(seed: int = 0) -> dict:
    key = jax.random.key(seed)
    ks = jax.random.split(key, 32)
    nrm = lambda k, shape, s: jax.random.normal(k, shape, f32) * s
    a_init = jax.random.uniform(ks[13], (DEPTH, 2, D_LRU), f32, 0.9, 0.999)
    root = a_init ** (1.0 / LRU_C)
    lru_lam = jnp.log(root) - jnp.log1p(-root)
    return {
        "x": nrm(ks[0], (BATCH, SEQ, D_MODEL), 1.0),
        "c": nrm(ks[1], (BATCH, D_MODEL), 1.0),
        "ctx": nrm(ks[2], (BATCH, CTX_LEN, D_MODEL), 1.0),
        "c_ctx": nrm(ks[3], (D_MODEL,), 1.0),
        "w_ada": nrm(ks[4], (DEPTH, D_MODEL, N_MOD * D_MODEL), 0.5 * D_MODEL ** -0.5),
        "b_ada": nrm(ks[5], (DEPTH, N_MOD * D_MODEL), 0.02),
        "w_in": nrm(ks[6], (DEPTH, D_MODEL, D_IN), D_MODEL ** -0.5),
        "conv_w": nrm(ks[7], (DEPTH, CONV_W, D_LRU), CONV_W ** -0.5),
        "conv_b": nrm(ks[8], (DEPTH, D_LRU), 0.02),
        "lru_wa": nrm(ks[9], (DEPTH, 2, LRU_BLOCKS, LRU_BLOCK_W, LRU_BLOCK_W), LRU_BLOCK_W ** -0.5),
        "lru_ba": nrm(ks[10], (DEPTH, 2, D_LRU), 0.02),
        "lru_wx": nrm(ks[11], (DEPTH, 2, LRU_BLOCKS, LRU_BLOCK_W, LRU_BLOCK_W), LRU_BLOCK_W ** -0.5),
        "lru_bx": nrm(ks[12], (DEPTH, 2, D_LRU), 0.02),
        "lru_lam": lru_lam,
        "gla_wa": nrm(ks[14], (DEPTH, 2, GATE_RANK, D_GLA_K), GATE_RANK ** -0.5),
        "gla_ba": nrm(ks[15], (DEPTH, 2, D_GLA_K), 0.1),
        "gla_norm_g": 1.0 + nrm(ks[16], (DEPTH, D_GLA_V), 0.02),
        "w_out": nrm(ks[17], (DEPTH, D_MIX, D_MODEL), DEEPNORM_BETA * D_MIX ** -0.5),
        "ln1_g": 1.0 + nrm(ks[18], (DEPTH, D_MODEL), 0.02),
        "ln1_b": nrm(ks[19], (DEPTH, D_MODEL), 0.02),
        "w_router": nrm(ks[20], (DEPTH, D_MODEL, N_EXPERTS), D_MODEL ** -0.5),
        "b_router": nrm(ks[21], (DEPTH, N_EXPERTS), 0.01),
        "w_gate": nrm(ks[22], (DEPTH, N_EXPERTS, D_MODEL, D_EXPERT), D_MODEL ** -0.5),
        "b_gate": nrm(ks[23], (DEPTH, N_EXPERTS, D_EXPERT), 0.02),
        "w_up": nrm(ks[24], (DEPTH, N_EXPERTS, D_MODEL, D_EXPERT), D_MODEL ** -0.5),
        "b_up": nrm(ks[25], (DEPTH, N_EXPERTS, D_EXPERT), 0.02),
        "w_down": nrm(ks[26], (DEPTH, N_EXPERTS, D_EXPERT, D_MODEL), DEEPNORM_BETA * D_EXPERT ** -0.5),
        "b_down": nrm(ks[27], (DEPTH, N_EXPERTS, D_MODEL), 0.02),
        "ln2_g": 1.0 + nrm(ks[28], (DEPTH, D_MODEL), 0.02),
        "ln2_b": nrm(ks[29], (DEPTH, D_MODEL), 0.02),
    }


def reference(x, c, ctx, c_ctx, w_ada, b_ada, w_in, conv_w, conv_b, lru_wa, lru_ba, lru_wx, lru_bx,
              lru_lam, gla_wa, gla_ba, gla_norm_g, w_out, ln1_g, ln1_b, w_router, b_router, w_gate,
              b_gate, w_up, b_up, w_down, b_down, ln2_g, ln2_b):
    B_ = x.shape[0]
    rows = x.shape[1] // GRID_W
    zero_lru = jnp.zeros((2, B_, D_LRU), f32)
    zero_gla = jnp.zeros((2, B_, GLA_HEADS, GLA_DK, GLA_DV), f32)
    for l in range(DEPTH):
        sh1, sc1, g1, sh2, sc2, g2 = ada_mod(c, w_ada[l], b_ada[l])
        sh1c, sc1c, g1c, sh2c, sc2c, g2c = ada_mod(c_ctx[None], w_ada[l], b_ada[l])
        mix_params = (w_in[l], conv_w[l], conv_b[l], lru_wa[l], lru_ba[l], lru_wx[l], lru_bx[l],
                      lru_lam[l], gla_wa[l], gla_ba[l])
        raw_ctx, lru_ctx_state, gla_ctx_state = mix_stream(
            modulate(ctx, sh1c, sc1c), None, zero_lru, zero_gla, *mix_params)
        raw_lat, _, _ = mix_stream(
            modulate(x, sh1, sc1), rows, lru_ctx_state, gla_ctx_state, *mix_params)
        y = merge_heads(*raw_lat, gla_norm_g[l], w_out[l])
        x = layer_norm(DEEPNORM_ALPHA * x + g1 * y, ln1_g[l], ln1_b[l])
        moe_params = (w_router[l], b_router[l], w_gate[l], b_gate[l], w_up[l], b_up[l], w_down[l], b_down[l])
        x = layer_norm(DEEPNORM_ALPHA * x + g2 * moe_ffn(modulate(x, sh2, sc2), *moe_params),
                       ln2_g[l], ln2_b[l])
        if l < DEPTH - 1:
            y_c = merge_heads(*raw_ctx, gla_norm_g[l], w_out[l])
            ctx = layer_norm(DEEPNORM_ALPHA * ctx + g1c * y_c, ln1_g[l], ln1_b[l])
            ctx = layer_norm(DEEPNORM_ALPHA * ctx + g2c * moe_ffn(modulate(ctx, sh2c, sc2c), *moe_params),
                             ln2_g[l], ln2_b[l])
    return x
```

```cpp
#include <hip/hip_runtime.h>
#include <cstdio>
#include <cstdint>

typedef unsigned short bf16;
typedef float f32x4 __attribute__((ext_vector_type(4)));

constexpr int D = 1024, BATCH = 4, SEQ = 4096, CTXL = 256, GW = 64;
constexpr int T = BATCH * SEQ;
constexpr int TC = BATCH * CTXL;
constexpr int MR = T + TC;
constexpr int DLRU = 512, NBLK = 8, BW = 64;
constexpr int HEADS = 4, DK = 64, DV = 128, DGK = 256, DGV = 512, RANK = 16;
constexpr int DIN = 2576, PP = 2560;
constexpr int NE = 32, TOPK = 4;
constexpr int NMOD = 6;
constexpr float ALPHA = 1.189207115002721f;
constexpr float LN_EPS = 1e-5f, RMS_EPS = 1e-6f;
constexpr int MAXTILES = 544;

constexpr size_t MiB = 1u << 20;
constexpr size_t al(size_t x) { return (x + 255) & ~(size_t)255; }
constexpr size_t WS_CTL = 0, CTL_ZERO_BYTES = 65536;
constexpr size_t WS_MOD = 1 * MiB;
constexpr size_t WS_ROUTE_E = WS_MOD + al(5 * 6144 * 4);
constexpr size_t WS_ROUTE_W = WS_ROUTE_E + al((size_t)T * 4 * 4);
constexpr size_t WS_LIST = WS_ROUTE_W + al((size_t)T * 4 * 4);
constexpr size_t WS_ALOW = WS_LIST + al((size_t)NE * T * 4);
constexpr size_t WS_WTL = WS_ALOW + al((size_t)MR * RANK * 4);
constexpr size_t WS_SMALL_END = WS_WTL + al((size_t)2 * 2 * 8 * 64 * 64 * 2);
static_assert(WS_SMALL_END <= 8 * MiB, "small region");
constexpr int NIN = 2816;
constexpr size_t WS_WTIN = 8 * MiB;
constexpr size_t WS_WTOUT = WS_WTIN + (size_t)NIN * D * 2;
constexpr size_t WS_WGU = WS_WTOUT + (size_t)D * D * 2;
constexpr size_t WS_WDN = WS_WGU + (size_t)NE * 2048 * D;
constexpr size_t WS_E = WS_WDN + (size_t)NE * D * D;
constexpr size_t WS_U = WS_E;
constexpr size_t WS_P = WS_U + (size_t)MR * D * 2;
constexpr size_t WS_AGG = WS_P + (size_t)MR * PP * 2;
constexpr size_t WS_CARRY = WS_AGG + al((size_t)272 * 2 * 2 * 512 * 4);
constexpr size_t WS_DEC = WS_CARRY + al((size_t)256 * 2 * 512 * 4);
constexpr size_t WS_MIX_END = WS_DEC + al((size_t)1088 * 2 * 64 * 4);
constexpr size_t WS_ACT = WS_E;
constexpr size_t WS_E_END = WS_MIX_END;
static_assert(WS_ACT + (size_t)MAXTILES * 128 * D <= WS_E_END, "region E");
constexpr size_t WS_F = WS_E_END;
constexpr size_t WS_Y = WS_F;
constexpr size_t WS_H = WS_F;
constexpr size_t WS_KV = WS_F + (size_t)T * D * 2;
constexpr size_t WS_YBUF = WS_F;
constexpr size_t WS_Z = WS_F + (size_t)T * 4 * D;
constexpr size_t WS_END = WS_F + (size_t)T * 4 * D * 2;
static_assert(WS_Z >= WS_F + (size_t)T * D * 2 && WS_Z + (size_t)T * D * 2 <= WS_END, "z in region F");
static_assert(WS_KV + (size_t)1088 * 2 * 128 * 64 * 4 <= WS_END, "kv in region F");
static_assert(WS_END <= 512 * MiB, "workspace map exceeds 512 MiB");

__device__ __forceinline__ float bf2f(bf16 v) { return __uint_as_float(((unsigned)v) << 16); }
__device__ __forceinline__ bf16 f2bf(float f) { unsigned u = __float_as_uint(f); u += 0x7fffu + ((u >> 16) & 1u); return (bf16)(u >> 16); }
__device__ __forceinline__ float sigmoidf_(float x) { return 1.0f / (1.0f + __expf(-x)); }
__device__ __forceinline__ float siluf_(float x) { return x * sigmoidf_(x); }
__device__ __forceinline__ float gelu_tanh(float x) { const float u = 0.7978845608028654f * (x + 0.044715f * x * x * x); return 0.5f * x * (1.0f + tanhf(u)); }
__device__ __forceinline__ float log_sigmoid(float z) { return -(fmaxf(-z, 0.f) + log1pf(__expf(-fabsf(z)))); }
template <int CTRL> __device__ __forceinline__ float dppf(float v) { return __builtin_bit_cast(float, __builtin_amdgcn_update_dpp(0, __builtin_bit_cast(int, v), CTRL, 0xF, 0xF, true)); }
constexpr int DPP_XOR1 = 0xB1  , DPP_XOR2 = 0x4E  , DPP_XOR7 = 0x141  , DPP_XOR15 = 0x140  ;
__device__ __forceinline__ float rdlane(float v, int l) { return __builtin_bit_cast(float, __builtin_amdgcn_readlane(__builtin_bit_cast(int, v), l)); }
__device__ __forceinline__ float wave_sum(float v) {
    v += dppf<DPP_XOR1>(v); v += dppf<DPP_XOR2>(v); v += dppf<DPP_XOR7>(v); v += dppf<DPP_XOR15>(v);
    return (rdlane(v, 0) + rdlane(v, 16)) + (rdlane(v, 32) + rdlane(v, 48));
}
__device__ __forceinline__ float wave_max(float v) {
    v = fmaxf(v, dppf<DPP_XOR1>(v)); v = fmaxf(v, dppf<DPP_XOR2>(v)); v = fmaxf(v, dppf<DPP_XOR7>(v)); v = fmaxf(v, dppf<DPP_XOR15>(v));
    return fmaxf(fmaxf(rdlane(v, 0), rdlane(v, 16)), fmaxf(rdlane(v, 32), rdlane(v, 48)));
}

struct In {
    const float *x, *c, *ctx, *c_ctx, *w_ada, *b_ada, *w_in, *conv_w, *conv_b, *lru_wa, *lru_ba, *lru_wx, *lru_bx, *lru_lam,
        *gla_wa, *gla_ba, *gla_norm_g, *w_out, *ln1_g, *ln1_b, *w_router, *b_router, *w_gate, *b_gate, *w_up, *b_up, *w_down, *b_down, *ln2_g, *ln2_b;
};

#define LAS __attribute__((address_space(3)))
#define GAS __attribute__((address_space(1)))
typedef short bf16x8 __attribute__((ext_vector_type(8)));
typedef unsigned u32x4 __attribute__((ext_vector_type(4)));
typedef unsigned u32x2 __attribute__((ext_vector_type(2)));
typedef float f32x2 __attribute__((ext_vector_type(2)));

constexpr int NWAVES = 8, NTHR = 512;
constexpr int RING_BYTES = 131072, SCR_BYTES = 147456  , LDSCTL_OFF = SCR_BYTES, LDSTBL_OFF = SCR_BYTES + 512  , LDSTOK_OFF = SCR_BYTES + 1536, LDS_BYTES = 163840;
constexpr int MAXU_GU = 28, MAXU_DN = 14;
static_assert(LDSTOK_OFF + MAXU_GU * 512 <= LDS_BYTES && LDSTOK_OFF + MAXU_DN * 1024 <= LDS_BYTES && LDSTBL_OFF + 320 + 4 * MAXU_GU * 4 + 16 <= LDSTOK_OFF, "LDS tables");

__device__ __forceinline__ unsigned cvt_pk_bf16(float lo, float hi) { unsigned r; asm volatile("v_cvt_pk_bf16_f32 %0, %1, %2" : "=v"(r) : "v"(lo), "v"(hi)); return r; }
__device__ __forceinline__ unsigned pk2(float lo, float hi) { return (unsigned)f2bf(lo) | ((unsigned)f2bf(hi) << 16); }
#define LDS_WAIT() asm volatile("s_waitcnt lgkmcnt(0)" ::: "memory")
#define VM_WAIT() asm volatile("s_waitcnt vmcnt(0)" ::: "memory")

namespace pg8 {
constexpr int BM = 256, BK = 64, HALF = 128, HTB = HALF * BK * 2  , STAGE_BYTES = 8 * HTB, NXCD = 8, WGM = 8;
__host__ __device__ __forceinline__ int lds_byte(int r, int c) { const int st = (r >> 4) * 2 + (c >> 5), rr = r & 15, cc = c & 31, ob = rr * 64 + cc * 2; return st * 1024 + (ob ^ (((ob >> 9) & 1) << 5)); }
__host__ __device__ __forceinline__ void stage_rc(int b, int& R, int& C) { const int st = b / 1024, sb = b % 1024, swz = sb ^ (((sb >> 9) & 1) << 5); R = (st >> 1) * 16 + swz / 64; C = (st & 1) * 32 + (swz % 64) / 2; }
__host__ __device__ __forceinline__ int perm32(int rho) { const int n = rho >> 4, i = rho & 15; return 8 * (i >> 2) + 4 * n + (i & 3); }

struct Unit { int pm, pn, e, ord; };
struct Gemm { const void* A; const void* Bt; int Kb; };

struct StaticOrder {
    int nM, nN, nwg, G, c, Kb;
    __device__ void init(int M, int N, int Kb_, int G_, int c_) { nM = M / BM; nN = N / BM; nwg = nM * nN; G = G_; c = c_; Kb = Kb_; }
    __device__ bool next(int i, Unit& u) const {
        const long L = (long)i * G + c; if (L >= nwg) return false;
        int wgid = (int)L; { const int q = nwg / NXCD, r = nwg % NXCD, xcd = wgid % NXCD, off = wgid / NXCD; wgid = (xcd < r ? xcd * (q + 1) : r * (q + 1) + (xcd - r) * q) + off; }
        const int nig = WGM * nN, gid = wgid / nig, fm = gid * WGM, gsz = (nM - fm) < WGM ? (nM - fm) : WGM;
        u.pm = fm + ((wgid % nig) % gsz); u.pn = (wgid % nig) / gsz; u.e = 0; u.ord = i; return true;
    }
    __device__ __forceinline__ unsigned a_off(const Unit& u, int h, int R) const { return (unsigned)(u.pm * BM + h * HALF + R) * (unsigned)Kb; }
};
struct MoeOrder {
    const LAS int* tb; const LAS unsigned* tok; int NT, G, c, U, Kb, gather;
    __device__ bool next(int i, Unit& u) const {
        const int L = i * G + c; if (L >= U) return false;
        int w; { const int q = U / NXCD, r = U % NXCD, xcd = L % NXCD, off = L / NXCD; w = (xcd < r ? xcd * (q + 1) : r * (q + 1) + (xcd - r) * q) + off; }
        int e = 0; while (e < NE - 1 && w >= __builtin_amdgcn_readfirstlane(tb[e + 1]) * NT) ++e;
        const int tbe = __builtin_amdgcn_readfirstlane(tb[e]), tiles = __builtin_amdgcn_readfirstlane(tb[e + 1]) - tbe, idx = w - tbe * NT;
        int mt, pn;
        if (NT == 8) { const int hi = idx / (tiles * 4), rem = idx - hi * tiles * 4; mt = rem >> 2; pn = hi * 4 + (rem & 3); } else { mt = idx >> 2; pn = idx & 3; }
        u.pm = tbe + mt; u.pn = e * NT + pn; u.e = e; u.ord = i; return true;
    }
    __device__ __forceinline__ unsigned a_off(const Unit& u, int h, int R) const { return gather ? tok[u.ord * 256 + h * HALF + R] : (unsigned)(u.pm * BM + h * HALF + R) * (unsigned)Kb; }
};

struct EpiInProj {
    static constexpr bool PERM = true;
    bf16* P; float* alow;
    static __device__ __forceinline__ int prow(int m, bool cm) { return (cm && m < T) ? ((m & ~(SEQ - 1)) | ((m & (GW - 1)) << 6) | ((m >> 6) & (GW - 1))) : m; }
    __device__ __forceinline__ void operator()(const f32x4 (&acc)[2][2][4][2], const Unit& u, int wr, int wc, int fr, int fq) const {
        const int row0 = u.pm * BM + wr * 64 + fr; const bool cm = u.pn >= 4;
        if (u.pn < 10) {
            const int col0 = u.pn * BM + wc * 32 + 8 * fq;
#pragma unroll
            for (int ai = 0; ai < 2; ++ai)
#pragma unroll
                for (int m = 0; m < 4; ++m) { bf16* rowp = P + (size_t)prow(row0 + ai * HALF + m * 16, cm) * PP + col0;
#pragma unroll
                    for (int bj = 0; bj < 2; ++bj) { const f32x4 v0 = acc[ai][bj][m][0], v1 = acc[ai][bj][m][1];
                        u32x4 w; w.x = cvt_pk_bf16(v0[0], v0[1]); w.y = cvt_pk_bf16(v0[2], v0[3]); w.z = cvt_pk_bf16(v1[0], v1[1]); w.w = cvt_pk_bf16(v1[2], v1[3]);
                        *(u32x4*)(rowp + bj * HALF) = w; } }
        } else if (wc == 0 && fq < 2) {
#pragma unroll
            for (int ai = 0; ai < 2; ++ai)
#pragma unroll
                for (int m = 0; m < 4; ++m) { float* rowp = alow + (size_t)prow(row0 + ai * HALF + m * 16, true) * RANK + 8 * fq;
                    *(f32x4*)(rowp) = acc[ai][0][m][0]; *(f32x4*)(rowp + 4) = acc[ai][0][m][1]; }
        }
    }
};
constexpr int ZP = D;
struct EpiOutProj {
    static constexpr bool PERM = true;
    const float* x; const float* mod; bf16* z;
    __device__ __forceinline__ void operator()(const f32x4 (&acc)[2][2][4][2], const Unit& u, int wr, int wc, int fr, int fq) const {
        const int row0 = u.pm * BM + wr * 64 + fr, col0 = u.pn * BM + wc * 32 + 8 * fq;
        const float* g1 = mod + (u.pm / 16) * 6144 + 2048;
        f32x4 gv[2][2];
#pragma unroll
        for (int bj = 0; bj < 2; ++bj)
#pragma unroll
            for (int n = 0; n < 2; ++n) gv[bj][n] = *(const f32x4*)(g1 + col0 + bj * HALF + n * 4);
#pragma unroll
        for (int ai = 0; ai < 2; ++ai)
#pragma unroll
            for (int m = 0; m < 4; ++m) { const size_t off = (size_t)(row0 + ai * HALF + m * 16) * D + col0;
#pragma unroll
                for (int bj = 0; bj < 2; ++bj) { const f32x4 x0 = *(const f32x4*)(x + off + bj * HALF), x1 = *(const f32x4*)(x + off + bj * HALF + 4);
                    const f32x4 v0 = x0 * ALPHA + gv[bj][0] * acc[ai][bj][m][0], v1 = x1 * ALPHA + gv[bj][1] * acc[ai][bj][m][1];
                    u32x4 w; w.x = cvt_pk_bf16(v0[0], v0[1]); w.y = cvt_pk_bf16(v0[2], v0[3]); w.z = cvt_pk_bf16(v1[0], v1[1]); w.w = cvt_pk_bf16(v1[2], v1[3]);
                    *(u32x4*)(z + (size_t)(row0 + ai * HALF + m * 16) * ZP + col0 + bj * HALF) = w; } }
    }
};
struct EpiGU {
    static constexpr bool PERM = true;
    const float* b_gate; const float* b_up; unsigned char* act;
    __device__ __forceinline__ void operator()(const f32x4 (&acc)[2][2][4][2], const Unit& u, int wr, int wc, int fr, int fq) const {
        const int row0 = u.pm * BM + wr * 64 + fr, col0 = (u.pn & 7) * 128 + wc * 32 + 8 * fq;
        f32x4 bg[2], bu[2];
#pragma unroll
        for (int n = 0; n < 2; ++n) { bg[n] = *(const f32x4*)(b_gate + u.e * D + col0 + 4 * n); bu[n] = *(const f32x4*)(b_up + u.e * D + col0 + 4 * n); }
#pragma unroll
        for (int ai = 0; ai < 2; ++ai)
#pragma unroll
            for (int m = 0; m < 4; ++m) { unsigned char* rowp = act + (size_t)(row0 + ai * HALF + m * 16) * D + col0;
                float o[8];
#pragma unroll
                for (int n = 0; n < 2; ++n)
#pragma unroll
                    for (int j = 0; j < 4; ++j) { const float g = fminf(acc[ai][0][m][n][j] + bg[n][j], 7.0f); const float up = fminf(fmaxf(acc[ai][1][m][n][j] + bu[n][j], -7.0f), 7.0f);
                        o[n * 4 + j] = (up + 1.0f) * g * __builtin_amdgcn_rcpf(1.0f + __expf(-1.702f * g)); }
                u32x2 w; w.x = 0u; w.y = 0u;
                w.x = __builtin_amdgcn_cvt_pk_fp8_f32(o[0], o[1], w.x, false); w.x = __builtin_amdgcn_cvt_pk_fp8_f32(o[2], o[3], w.x, true);
                w.y = __builtin_amdgcn_cvt_pk_fp8_f32(o[4], o[5], w.y, false); w.y = __builtin_amdgcn_cvt_pk_fp8_f32(o[6], o[7], w.y, true);
                *(u32x2*)rowp = w; }
    }
};
struct EpiDown {
    static constexpr bool PERM = true;
    const float* b_down; bf16* ybuf; const LAS int* dtab; const LAS float* wtab;
    __device__ __forceinline__ void operator()(const f32x4 (&acc)[2][2][4][2], const Unit& u, int wr, int wc, int fr, int fq) const {
        const int rl0 = wr * 64 + fr, col0 = (u.pn & 3) * BM + wc * 32 + 8 * fq;
        f32x4 bv[2][2];
#pragma unroll
        for (int bj = 0; bj < 2; ++bj)
#pragma unroll
            for (int n = 0; n < 2; ++n) bv[bj][n] = *(const f32x4*)(b_down + u.e * D + col0 + bj * HALF + 4 * n);
#pragma unroll
        for (int ai = 0; ai < 2; ++ai)
#pragma unroll
            for (int m = 0; m < 4; ++m) { const int rl = rl0 + ai * HALF + m * 16; const int dest = dtab[u.ord * 256 + rl]; const float wg = wtab[u.ord * 256 + rl];
                if (dest >= 0) { bf16* rowp = ybuf + (size_t)dest * D + col0;
#pragma unroll
                    for (int bj = 0; bj < 2; ++bj) { const f32x4 v0 = (acc[ai][bj][m][0] + bv[bj][0]) * wg, v1 = (acc[ai][bj][m][1] + bv[bj][1]) * wg;
                        u32x4 w; w.x = cvt_pk_bf16(v0[0], v0[1]); w.y = cvt_pk_bf16(v0[2], v0[3]); w.z = cvt_pk_bf16(v1[0], v1[1]); w.w = cvt_pk_bf16(v1[2], v1[3]);
                        *(u32x4*)(rowp + bj * HALF) = w; } } }
    }
};

typedef int v8i __attribute__((ext_vector_type(8)));
typedef int v4i __attribute__((ext_vector_type(4)));
__device__ __forceinline__ const char* uptr(const char* p) { const unsigned long long v = (unsigned long long)p; const unsigned lo = __builtin_amdgcn_readfirstlane((unsigned)v), hi = __builtin_amdgcn_readfirstlane((unsigned)(v >> 32)); return (const char*)(((unsigned long long)hi << 32) | lo); }
template <class Epi, class Sched, bool ALIGN_EPI, bool F8>
__device__ __forceinline__ void gemm_phase(LAS unsigned char* lds, const Gemm g, const Sched& S, const Epi& E) {
    const int tid = threadIdx.x, wid = __builtin_amdgcn_readfirstlane(tid >> 6), lane = tid & 63, wr = wid >> 2, wc = wid & 3, fr = lane & 15, fq = lane >> 4;
    const int Kb = g.Kb, nt = Kb / 128;
    unsigned voffB[2];
#pragma unroll
    for (int i = 0; i < 2; ++i) { int R, C; stage_rc(tid * 16 + i * 8192, R, C); const int Rb = Epi::PERM ? ((R & ~31) + perm32(R & 31)) : R;
        voffB[i] = (unsigned)(Rb * Kb + C * 2); }
    const size_t kstep = (size_t)128;
    const size_t hstep = (size_t)HALF * Kb;
    const size_t tstep = 2 * hstep;
    const unsigned ldsw = (unsigned)wid * 1024u;
    const int aoff = F8 ? lds_byte(wr * 64 + fr, fq * 16) : lds_byte(wr * 64 + fr, fq * 8), boff = F8 ? lds_byte(wc * 32 + fr, fq * 16) : lds_byte(wc * 32 + fr, fq * 8);
#define PG8_SA(b, h) (((b) * 2 + (h)) * HTB)
#define PG8_SB(b, h) ((4 + (b) * 2 + (h)) * HTB)
#define PG8_STAGE2(bufoff, gbase, h_) do { _Pragma("unroll") for (int _i = 0; _i < 2; ++_i) \
        __builtin_amdgcn_global_load_lds((const unsigned*)(uptr((const char*)(gbase)) + (last ? nvo[h_][_i] : vo[h_][_i])), (LAS unsigned*)(lds + (bufoff) + ldsw + _i * 8192), 16, 0, 0); } while (0)
#define PG8_STAGE(bufoff, gbase, voff) do { _Pragma("unroll") for (int _i = 0; _i < 2; ++_i) { unsigned _o = (voff)[_i]; asm volatile("" : "+v"(_o));     \
        __builtin_amdgcn_global_load_lds((const unsigned*)(uptr((const char*)(gbase)) + _o), (LAS unsigned*)(lds + (bufoff) + ldsw + _i * 8192), 16, 0, 0); } } while (0)
#define PG8_LDA(dst, b, h) do { if constexpr (F8) { _Pragma("unroll") for (int m = 0; m < 4; ++m) { const LAS v4i* _p = (const LAS v4i*)(lds + PG8_SA(b, h) + aoff + m * 2048); dst##8[m] = __builtin_shufflevector(_p[0], _p[1], 0, 1, 2, 3, 4, 5, 6, 7); } } \
        else { _Pragma("unroll") for (int m = 0; m < 4; ++m) _Pragma("unroll") for (int k = 0; k < 2; ++k) dst[m][k] = *(const LAS bf16x8*)(lds + PG8_SA(b, h) + aoff + m * 2048 + k * 1024); } } while (0)
#define PG8_LDB(dst, b, h) do { if constexpr (F8) { _Pragma("unroll") for (int n = 0; n < 2; ++n) { const LAS v4i* _p = (const LAS v4i*)(lds + PG8_SB(b, h) + boff + n * 2048); dst##8[n] = __builtin_shufflevector(_p[0], _p[1], 0, 1, 2, 3, 4, 5, 6, 7); } } \
        else { _Pragma("unroll") for (int n = 0; n < 2; ++n) _Pragma("unroll") for (int k = 0; k < 2; ++k) dst[n][k] = *(const LAS bf16x8*)(lds + PG8_SB(b, h) + boff + n * 2048 + k * 1024); } } while (0)
#define PG8_MMA(ai, bj, At, Bt) do { __builtin_amdgcn_s_setprio(1); if constexpr (F8) { _Pragma("unroll") for (int m = 0; m < 4; ++m) _Pragma("unroll") for (int n = 0; n < 2; ++n) \
        acc[ai][bj][m][n] = __builtin_amdgcn_mfma_scale_f32_16x16x128_f8f6f4(Bt##8[n], At##8[m], acc[ai][bj][m][n], 0, 0, 0, 0x79797979, 0, 0x7F7F7F7F); } \
        else { _Pragma("unroll") for (int m = 0; m < 4; ++m) _Pragma("unroll") for (int n = 0; n < 2; ++n) _Pragma("unroll") for (int k = 0; k < 2; ++k) \
        acc[ai][bj][m][n] = __builtin_amdgcn_mfma_f32_16x16x32_bf16(Bt[n][k], At[m][k], acc[ai][bj][m][n], 0, 0, 0); } __builtin_amdgcn_s_setprio(0); } while (0)
#define PG8_WAIT_V(n) asm volatile("s_waitcnt vmcnt(" #n ")" ::: "memory")
#define PG8_WAIT_L(n) asm volatile("s_waitcnt lgkmcnt(" #n ")" ::: "memory")
#define PG8_BAR __builtin_amdgcn_s_barrier()
#define PG8_SCHED __builtin_amdgcn_sched_barrier(0)
#define PG8_AOFF(dst, u) do { _Pragma("unroll") for (int _i = 0; _i < 2; ++_i) { int _R, _C; stage_rc((int)threadIdx.x * 16 + _i * 8192, _R, _C); _Pragma("unroll") for (int _h = 0; _h < 2; ++_h) dst[_h][_i] = S.a_off(u, _h, _R) + (unsigned)(_C * 2); } } while (0)
    Unit cur, nxt; int ui = 0;
    if (!S.next(0, cur)) return;
    f32x4 acc[2][2][4][2];
#pragma unroll
    for (int a = 0; a < 2; ++a)
#pragma unroll
        for (int b = 0; b < 2; ++b)
#pragma unroll
            for (int m = 0; m < 4; ++m)
#pragma unroll
                for (int n = 0; n < 2; ++n) acc[a][b][m][n] = (f32x4){0.f, 0.f, 0.f, 0.f};
    bf16x8 At[4][2], B0[2][2], B1[2][2]; v8i At8[4], B08[2], B18[2];
    unsigned vo[2][2], nvo[2][2];
    PG8_AOFF(vo, cur);
    const char* gA = (const char*)g.A; const char* cB = (const char*)g.Bt + (size_t)cur.pn * tstep;
    PG8_STAGE(PG8_SB(0, 0), cB, voffB); PG8_STAGE(PG8_SB(0, 1), cB + hstep, voffB); PG8_STAGE(PG8_SA(0, 0), gA, vo[0]); PG8_STAGE(PG8_SA(0, 1), gA, vo[1]);
    if (wr == 1) PG8_BAR;
    PG8_WAIT_V(2); PG8_BAR;
    PG8_STAGE(PG8_SB(1, 0), cB + kstep, voffB); PG8_STAGE(PG8_SA(1, 0), gA + kstep, vo[0]); PG8_STAGE(PG8_SB(1, 1), cB + hstep + kstep, voffB);
    PG8_WAIT_V(6); PG8_BAR;
    for (;;) {
        const bool has_next = S.next(ui + 1, nxt);
        const char* nB = has_next ? (const char*)g.Bt + (size_t)nxt.pn * tstep : cB;
        if (has_next) { PG8_AOFF(nvo, nxt); } else {
#pragma unroll
            for (int h = 0; h < 2; ++h)
#pragma unroll
                for (int i = 0; i < 2; ++i) nvo[h][i] = vo[h][i]; }
#pragma unroll 1
        for (int t = 0; t < nt; t += 2) {
            const bool last = (t == nt - 2);
            const char* ka1 = gA + (size_t)(t + 1) * kstep;
            const char* ka2 = last ? gA : gA + (size_t)(t + 2) * kstep; const char* b2 = last ? nB : cB + (size_t)(t + 2) * kstep;
            const char* ka3 = ka2 + kstep; const char* b3 = b2 + kstep;
            PG8_LDB(B0, 0, 0); PG8_LDB(B1, 0, 1); PG8_SCHED; PG8_LDA(At, 0, 0); PG8_STAGE(PG8_SA(1, 1), ka1, vo[1]);
            PG8_WAIT_V(8); PG8_WAIT_L(0); PG8_BAR; PG8_SCHED; PG8_MMA(0, 0, At, B0); PG8_MMA(0, 1, At, B1); PG8_SCHED; PG8_BAR; PG8_SCHED;
            PG8_LDA(At, 0, 1); PG8_STAGE(PG8_SB(0, 0), b2, voffB); PG8_STAGE(PG8_SB(0, 1), b2 + hstep, voffB); PG8_STAGE2(PG8_SA(0, 0), ka2, 0);
            PG8_WAIT_V(8); PG8_WAIT_L(0); PG8_BAR; PG8_SCHED; PG8_MMA(1, 0, At, B0); PG8_MMA(1, 1, At, B1); PG8_SCHED; PG8_BAR; PG8_SCHED;
            PG8_LDB(B0, 1, 0); PG8_LDB(B1, 1, 1); PG8_SCHED; PG8_LDA(At, 1, 0); PG8_STAGE2(PG8_SA(0, 1), ka2, 1);
            PG8_WAIT_V(8); PG8_WAIT_L(0); PG8_BAR; PG8_SCHED; PG8_MMA(0, 0, At, B0); PG8_MMA(0, 1, At, B1); PG8_SCHED; PG8_BAR; PG8_SCHED;
            PG8_LDA(At, 1, 1); PG8_STAGE(PG8_SB(1, 0), b3, voffB); PG8_STAGE(PG8_SB(1, 1), b3 + hstep, voffB); PG8_STAGE2(PG8_SA(1, 0), ka3, 0);
            PG8_WAIT_V(8); PG8_WAIT_L(0); PG8_BAR; PG8_SCHED; PG8_MMA(1, 0, At, B0); PG8_MMA(1, 1, At, B1); PG8_SCHED; PG8_BAR; PG8_SCHED;
        }
        if constexpr (ALIGN_EPI) { if (wr == 0) PG8_BAR; }
        E(acc, cur, wr, wc, fr, fq);
        if (!has_next) break;
#pragma unroll
        for (int a = 0; a < 2; ++a)
#pragma unroll
            for (int b = 0; b < 2; ++b)
#pragma unroll
                for (int m = 0; m < 4; ++m)
#pragma unroll
                    for (int n = 0; n < 2; ++n) acc[a][b][m][n] = (f32x4){0.f, 0.f, 0.f, 0.f};
        cur = nxt; cB = nB; ++ui;
#pragma unroll
        for (int h = 0; h < 2; ++h)
#pragma unroll
            for (int i = 0; i < 2; ++i) vo[h][i] = nvo[h][i];
        if constexpr (ALIGN_EPI) { if (wr == 1) PG8_BAR; }
    }
    PG8_WAIT_V(0);
    if constexpr (!ALIGN_EPI) { if (wr == 0) PG8_BAR; }
    PG8_BAR;
#undef PG8_SA
#undef PG8_SB
#undef PG8_STAGE
#undef PG8_STAGE2
#undef PG8_LDA
#undef PG8_LDB
#undef PG8_MMA
#undef PG8_WAIT_V
#undef PG8_WAIT_L
#undef PG8_BAR
#undef PG8_SCHED
#undef PG8_AOFF
}

struct MoeOrder8 {
    const LAS int* ut; const LAS unsigned* tok; int nu, Kb, gather;
    __device__ __forceinline__ bool next(int i, Unit& u) const {
        if (i >= nu) return false;
        u.pm = __builtin_amdgcn_readfirstlane(ut[4 * i]); u.pn = __builtin_amdgcn_readfirstlane(ut[4 * i + 1]); u.e = __builtin_amdgcn_readfirstlane(ut[4 * i + 2]); u.ord = i; return true;
    }
    __device__ __forceinline__ unsigned a_off(const Unit& u, int R) const { return gather ? tok[u.ord * 128 + R] : (unsigned)(u.pm * 128 + R) * (unsigned)Kb; }
};
__device__ __forceinline__ void moe_unit_table(const LAS int* tb, LAS int* ut, LAS int* nu_out, int NT, int G, int c, int cap, int tid) {
    const int U = tb[NE] * NT;
    if (tid < cap) {
        const int L = tid * G + c;
        if (L < U) {
            int w; { const int q = U / NXCD, r = U % NXCD, xcd = L % NXCD, off = L / NXCD; w = (xcd < r ? xcd * (q + 1) : r * (q + 1) + (xcd - r) * q) + off; }
            int e = 0; while (e < NE - 1 && w >= tb[e + 1] * NT) ++e;
            const int tbe = tb[e], tiles = tb[e + 1] - tbe, idx = w - tbe * NT;
            int mt, pn;
            if (NT == 8) { const int hi = idx / (tiles * 4), rem = idx - hi * tiles * 4; mt = rem >> 2; pn = hi * 4 + (rem & 3); } else { mt = idx >> 2; pn = idx & 3; }
            ut[4 * tid] = tbe + mt; ut[4 * tid + 1] = e * NT + pn; ut[4 * tid + 2] = e;
        }
    }
    if (tid == 0) { const int n = (U - c + G - 1) / G; *nu_out = n < 0 ? 0 : (n > cap ? cap : n); }
}
struct EpiGU8 {
    const float* b_gate; const float* b_up; unsigned char* act;
    struct Pre { f32x4 bg[2], bu[2]; };
    __device__ __forceinline__ void prefetch(Pre& p, const Unit& u, int wr, int wc, int fr, int fq) const {
        const int col0 = (u.pn & 7) * 128 + wc * 32 + 8 * fq;
#pragma unroll
        for (int n = 0; n < 2; ++n) { p.bg[n] = *(const f32x4*)(b_gate + u.e * D + col0 + 4 * n); p.bu[n] = *(const f32x4*)(b_up + u.e * D + col0 + 4 * n); }
    }
    __device__ __forceinline__ void operator()(const f32x4 (&acc)[2][4][2], const Pre& p, const Unit& u, int wr, int wc, int fr, int fq) const {
        const int row0 = u.pm * 128 + wr * 64 + fr, col0 = (u.pn & 7) * 128 + wc * 32 + 8 * fq;
#pragma unroll
        for (int m = 0; m < 4; ++m) { unsigned char* rowp = act + (size_t)(row0 + m * 16) * D + col0;
            float o[8];
#pragma unroll
            for (int n = 0; n < 2; ++n)
#pragma unroll
                for (int j = 0; j < 4; ++j) { const float gt = fminf(acc[0][m][n][j] + p.bg[n][j], 7.0f); const float up = fminf(fmaxf(acc[1][m][n][j] + p.bu[n][j], -7.0f), 7.0f);
                    o[n * 4 + j] = (up + 1.0f) * gt * __builtin_amdgcn_rcpf(1.0f + __builtin_amdgcn_exp2f(-2.4554669595930156f * gt)); }
            u32x2 w; w.x = 0u; w.y = 0u;
            w.x = __builtin_amdgcn_cvt_pk_fp8_f32(o[0], o[1], w.x, false); w.x = __builtin_amdgcn_cvt_pk_fp8_f32(o[2], o[3], w.x, true);
            w.y = __builtin_amdgcn_cvt_pk_fp8_f32(o[4], o[5], w.y, false); w.y = __builtin_amdgcn_cvt_pk_fp8_f32(o[6], o[7], w.y, true);
            *(u32x2*)rowp = w; }
    }
};
constexpr float YSCALE = 32.0f;
struct EpiDown8 {
    const float* b_down; unsigned char* ybuf; const LAS int* dtab; const LAS float* wtab;
    struct Pre { f32x4 bv[2][2]; };
    __device__ __forceinline__ void prefetch(Pre& p, const Unit& u, int wr, int wc, int fr, int fq) const {
        const int col0 = (u.pn & 3) * 256 + wc * 32 + 8 * fq;
#pragma unroll
        for (int bj = 0; bj < 2; ++bj)
#pragma unroll
            for (int n = 0; n < 2; ++n) p.bv[bj][n] = *(const f32x4*)(b_down + u.e * D + col0 + bj * 128 + 4 * n);
    }
    __device__ __forceinline__ void operator()(const f32x4 (&acc)[2][4][2], const Pre& p, const Unit& u, int wr, int wc, int fr, int fq) const {
        const int rl0 = wr * 64 + fr, col0 = (u.pn & 3) * 256 + wc * 32 + 8 * fq;
#pragma unroll
        for (int m = 0; m < 4; ++m) { const int rl = rl0 + m * 16; const int dest = dtab[u.ord * 128 + rl]; const float wg = wtab[u.ord * 128 + rl] * YSCALE;
            if (dest >= 0) { unsigned char* rowp = ybuf + (size_t)dest * D + col0;
#pragma unroll
                for (int bj = 0; bj < 2; ++bj) { const f32x4 v0 = (acc[bj][m][0] + p.bv[bj][0]) * wg, v1 = (acc[bj][m][1] + p.bv[bj][1]) * wg;
                    u32x2 w; w.x = 0u; w.y = 0u;
                    w.x = __builtin_amdgcn_cvt_pk_fp8_f32(v0[0], v0[1], w.x, false); w.x = __builtin_amdgcn_cvt_pk_fp8_f32(v0[2], v0[3], w.x, true);
                    w.y = __builtin_amdgcn_cvt_pk_fp8_f32(v1[0], v1[1], w.y, false); w.y = __builtin_amdgcn_cvt_pk_fp8_f32(v1[2], v1[3], w.y, true);
                    *(u32x2*)(rowp + bj * 128) = w; } } }
    }
};
template <class Epi>
__device__ __forceinline__ void gemm_phase8(LAS unsigned char* lds, const Gemm g, const MoeOrder8& S, const Epi& E) {
    const int tid = threadIdx.x, wid = __builtin_amdgcn_readfirstlane(tid >> 6), lane = tid & 63, wr = wid >> 2, wc = wid & 3, fr = lane & 15, fq = lane >> 4;
    const int Kb = g.Kb, nt = Kb / 128;
    unsigned voffB[2];
#pragma unroll
    for (int i = 0; i < 2; ++i) { int R, C; stage_rc(tid * 16 + i * 8192, R, C); const int Rb = (R & ~31) + perm32(R & 31); voffB[i] = (unsigned)(Rb * Kb + C * 2); }
    const size_t hstep = (size_t)HALF * Kb, tstep = 2 * hstep;
    const unsigned ldsw = (unsigned)wid * 1024u;
    const int aoff = lds_byte(wr * 64 + fr, fq * 16), boff = lds_byte(wc * 32 + fr, fq * 16);
    constexpr unsigned SLOT = 3 * HTB;
#define P8_STG(ldsoff, gbase, off_) do { _Pragma("unroll") for (int _i = 0; _i < 2; ++_i) { unsigned _o = (off_)[_i]; asm volatile("" : "+v"(_o)); \
        __builtin_amdgcn_global_load_lds((const unsigned*)(uptr((const char*)(gbase)) + _o), (LAS unsigned*)(lds + (ldsoff) + ldsw + _i * 8192), 16, 0, 0); } } while (0)
#define P8_AOFF(dst, u) do { _Pragma("unroll") for (int _i = 0; _i < 2; ++_i) { int _R, _C; stage_rc((int)threadIdx.x * 16 + _i * 8192, _R, _C); dst[_i] = S.a_off(u, _R) + (unsigned)(_C * 2); } } while (0)
#define P8_WAIT_V(n) asm volatile("s_waitcnt vmcnt(" #n ")" ::: "memory")
#define P8_WAIT_L(n) asm volatile("s_waitcnt lgkmcnt(" #n ")" ::: "memory")
#define P8_BAR __builtin_amdgcn_s_barrier()
#define P8_SCHED __builtin_amdgcn_sched_barrier(0)
    Unit cur, nxt; int ui = 0;
    if (!S.next(0, cur)) return;
    f32x4 acc[2][4][2];
#pragma unroll
    for (int b = 0; b < 2; ++b)
#pragma unroll
        for (int m = 0; m < 4; ++m)
#pragma unroll
            for (int n = 0; n < 2; ++n) acc[b][m][n] = (f32x4){0.f, 0.f, 0.f, 0.f};
    v8i At8[4], B08[2], B18[2];
    unsigned vo[2], nvo[2];
    P8_AOFF(vo, cur);
    const char* gA = (const char*)g.A; const char* cB = (const char*)g.Bt + (size_t)cur.pn * tstep;
    P8_STG(HTB, cB, voffB); P8_STG(2 * HTB, cB + hstep, voffB); P8_STG(0, gA, vo);
    P8_STG(SLOT + HTB, cB + 128, voffB); P8_STG(SLOT + 2 * HTB, cB + hstep + 128, voffB); P8_STG(SLOT, gA + 128, vo);
    P8_WAIT_V(6);
    if (wr == 1) P8_BAR;
    P8_BAR;
    unsigned rs = 0u, ws = 2u * SLOT;
    for (;;) {
        const bool has_next = S.next(ui + 1, nxt);
        const char* nB = has_next ? (const char*)g.Bt + (size_t)nxt.pn * tstep : cB;
        if (has_next) { P8_AOFF(nvo, nxt); } else { nvo[0] = vo[0]; nvo[1] = vo[1]; }
        typename Epi::Pre pre; E.prefetch(pre, cur, wr, wc, fr, fq);
#pragma unroll 1
        for (int t = 0; t < nt; ++t) {
            const bool wrap = (t + 2 >= nt); const int kt = wrap ? t + 2 - nt : t + 2;
            const char* kb = (wrap ? nB : cB) + (size_t)kt * 128; const char* ka = gA + (size_t)kt * 128;
            unsigned ao[2]; ao[0] = wrap ? nvo[0] : vo[0]; ao[1] = wrap ? nvo[1] : vo[1];
#pragma unroll
            for (int n = 0; n < 2; ++n) { const LAS v4i* p0 = (const LAS v4i*)(lds + rs + HTB + boff + n * 2048); const LAS v4i* p1 = (const LAS v4i*)(lds + rs + 2 * HTB + boff + n * 2048);
                B08[n] = __builtin_shufflevector(p0[0], p0[1], 0, 1, 2, 3, 4, 5, 6, 7); B18[n] = __builtin_shufflevector(p1[0], p1[1], 0, 1, 2, 3, 4, 5, 6, 7); }
            P8_SCHED;
#pragma unroll
            for (int m = 0; m < 4; ++m) { const LAS v4i* p = (const LAS v4i*)(lds + rs + aoff + m * 2048); At8[m] = __builtin_shufflevector(p[0], p[1], 0, 1, 2, 3, 4, 5, 6, 7); }
            P8_STG(ws + HTB, kb, voffB); P8_STG(ws + 2 * HTB, kb + hstep, voffB); P8_STG(ws, ka, ao);
            P8_WAIT_V(6); P8_WAIT_L(0); P8_BAR; P8_SCHED;
            __builtin_amdgcn_s_setprio(1);
#pragma unroll
            for (int m = 0; m < 4; ++m)
#pragma unroll
                for (int n = 0; n < 2; ++n) { acc[0][m][n] = __builtin_amdgcn_mfma_scale_f32_16x16x128_f8f6f4(B08[n], At8[m], acc[0][m][n], 0, 0, 0, 0x79797979, 0, 0x7F7F7F7F);
                                              acc[1][m][n] = __builtin_amdgcn_mfma_scale_f32_16x16x128_f8f6f4(B18[n], At8[m], acc[1][m][n], 0, 0, 0, 0x79797979, 0, 0x7F7F7F7F); }
            __builtin_amdgcn_s_setprio(0);
            P8_SCHED; P8_BAR; P8_SCHED;
            rs = (rs == 2u * SLOT) ? 0u : rs + SLOT; ws = (ws == 2u * SLOT) ? 0u : ws + SLOT;
        }
        if (wr == 0) P8_BAR;
        E(acc, pre, cur, wr, wc, fr, fq);
        if (!has_next) break;
#pragma unroll
        for (int b = 0; b < 2; ++b)
#pragma unroll
            for (int m = 0; m < 4; ++m)
#pragma unroll
                for (int n = 0; n < 2; ++n) acc[b][m][n] = (f32x4){0.f, 0.f, 0.f, 0.f};
        cur = nxt; cB = nB; ++ui; vo[0] = nvo[0]; vo[1] = nvo[1];
        if (wr == 1) P8_BAR;
    }
    P8_WAIT_V(0);
    P8_BAR;
#undef P8_STG
#undef P8_AOFF
#undef P8_WAIT_V
#undef P8_WAIT_L
#undef P8_BAR
#undef P8_SCHED
}
}

enum Phase { PH_SMALLW = 0, PH_WEXP = 1, PH_MOD = 2, PH_INPROJ = 3, PH_MIX1 = 4, PH_MIX2 = 5, PH_MIX3 = 6, PH_OUTPROJ = 7, PH_ROUTE = 8, PH_GU = 9, PH_DOWN = 10, PH_FINAL = 11 };
struct Args { In in; float* out; unsigned char* ws; unsigned phases; unsigned pad; };

__device__ __forceinline__ void tr_item(const float* W, int ldw, int k0, int n0, int nvalid, bf16* dst, int ldk, LAS float* scr, int lane) {
#pragma unroll 8
    for (int i = 0; i < 32; ++i) { const int kk = 2 * i + (lane >> 5), nn = lane & 31; scr[kk * 33 + nn] = nn < nvalid ? W[(size_t)(k0 + kk) * ldw + n0 + nn] : 0.f; }
    LDS_WAIT(); asm volatile("" ::: "memory");
    const int c = lane & 7;
#pragma unroll
    for (int j = 0; j < 4; ++j) { const int n = (lane >> 3) + 8 * j; const LAS float* sp = scr + (8 * c) * 33 + n;
        u32x4 o; o.x = pk2(sp[0 * 33], sp[1 * 33]); o.y = pk2(sp[2 * 33], sp[3 * 33]); o.z = pk2(sp[4 * 33], sp[5 * 33]); o.w = pk2(sp[6 * 33], sp[7 * 33]);
        if (n < nvalid) *(u32x4*)(dst + (size_t)n * ldk + k0 + 8 * c) = o; }
    LDS_WAIT(); asm volatile("" ::: "memory");
}


__device__ __forceinline__ void tr_item8(const float* W, int ldw, int k0, int n0, unsigned char* dst, int ldk, LAS float* scr, int lane) {
    f32x4 raw[8];
#pragma unroll
    for (int i = 0; i < 8; ++i) raw[i] = __builtin_nontemporal_load((const f32x4*)(W + (size_t)(k0 + i * 8 + (lane >> 3)) * ldw + n0 + (lane & 7) * 4));
#pragma unroll
    for (int i = 0; i < 8; ++i) { LAS float* sp = scr + (i * 8 + (lane >> 3)) * 33 + (lane & 7) * 4;
#pragma unroll
        for (int j = 0; j < 4; ++j) sp[j] = raw[i][j] * 64.0f; }
    LDS_WAIT(); asm volatile("" ::: "memory");
    const int c = lane & 7;
#pragma unroll
    for (int j = 0; j < 4; ++j) { const int n = (lane >> 3) + 8 * j; const LAS float* sp = scr + (8 * c) * 33 + n;
        u32x2 o; o.x = 0u; o.y = 0u;
        o.x = __builtin_amdgcn_cvt_pk_fp8_f32(sp[0 * 33], sp[1 * 33], o.x, false); o.x = __builtin_amdgcn_cvt_pk_fp8_f32(sp[2 * 33], sp[3 * 33], o.x, true);
        o.y = __builtin_amdgcn_cvt_pk_fp8_f32(sp[4 * 33], sp[5 * 33], o.y, false); o.y = __builtin_amdgcn_cvt_pk_fp8_f32(sp[6 * 33], sp[7 * 33], o.y, true);
        *(u32x2*)(dst + (size_t)n * ldk + k0 + 8 * c) = o; }
    LDS_WAIT(); asm volatile("" ::: "memory");
}

__device__ __forceinline__ float fast_sigmoid(float x) { return __builtin_amdgcn_rcpf(1.0f + __expf(-x)); }
__device__ __forceinline__ float gelu_tanh_fast(float x) { const float u = 1.5957691216057308f * (x + 0.044715f * x * x * x); return x * fast_sigmoid(u); }
__device__ __forceinline__ bf16x8 pack8(const float (&v)[8]) { u32x4 w; w.x = pk2(v[0], v[1]); w.y = pk2(v[2], v[3]); w.z = pk2(v[4], v[5]); w.w = pk2(v[6], v[7]); return __builtin_bit_cast(bf16x8, w); }
__device__ __forceinline__ void unpack8(const u32x4 w, float (&v)[8]) {
    v[0] = __uint_as_float(w.x << 16); v[1] = __uint_as_float(w.x & 0xffff0000u); v[2] = __uint_as_float(w.y << 16); v[3] = __uint_as_float(w.y & 0xffff0000u);
    v[4] = __uint_as_float(w.z << 16); v[5] = __uint_as_float(w.z & 0xffff0000u); v[6] = __uint_as_float(w.w << 16); v[7] = __uint_as_float(w.w & 0xffff0000u); }

constexpr int LRU_WAVE_LDS = 9216 + 8192;
template <bool FINAL, int DIR>
__device__ __forceinline__ void lru_dir(const In& in, const bf16* P, const bf16* WtL, int line, int cb, int m0, LAS unsigned char* xsl, LAS f32x2* abl, int lane, float* agg, const float* carry, bf16* Y) {
    constexpr int d = DIR;
    const int fr = lane & 15, fq = lane >> 4;
    bf16x8 bfr[2][4][2];
#pragma unroll
    for (int g = 0; g < 2; ++g)
#pragma unroll
        for (int nt = 0; nt < 4; ++nt)
#pragma unroll
            for (int ks = 0; ks < 2; ++ks) bfr[g][nt][ks] = *(const bf16x8*)(WtL + ((size_t)(((d * 2 + g) * 8 + cb) * 64 + nt * 16 + fr)) * 64 + ks * 32 + fq * 8);
    float ba[4], bx[4], cl[4];
#pragma unroll
    for (int nt = 0; nt < 4; ++nt) { const int ch = d * DLRU + cb * 64 + nt * 16 + fr; ba[nt] = in.lru_ba[ch]; bx[nt] = in.lru_bx[ch]; cl[nt] = -8.0f * 1.4426950408889634f * __logf(1.0f + __expf(-in.lru_lam[ch])); }
    float h = 0.f, aprod = 1.f;
    if (FINAL) h = carry[((size_t)line * 2 + d) * DLRU + cb * 64 + lane];
#pragma unroll 1
    for (int mi = 0; mi < 4; ++mi) {
        const int mt = d == 0 ? mi : 3 - mi;
        unsigned short gt[16], hq[16];
        if (FINAL && d == 1) {
#pragma unroll
            for (int t = 0; t < 16; ++t) { gt[t] = P[(size_t)(m0 + mt * 16 + t) * PP + 512 + cb * 64 + lane]; hq[t] = Y[(size_t)(m0 + mt * 16 + t) * D + cb * 64 + lane]; } }
        bf16x8 af[2];
#pragma unroll
        for (int ks = 0; ks < 2; ++ks) af[ks] = *(const LAS bf16x8*)(xsl + (mt * 16 + fr) * 144 + ks * 64 + fq * 16);
        f32x4 acc[2][4];
#pragma unroll
        for (int g = 0; g < 2; ++g)
#pragma unroll
            for (int nt = 0; nt < 4; ++nt) { acc[g][nt] = (f32x4){0.f, 0.f, 0.f, 0.f};
#pragma unroll
                for (int ks = 0; ks < 2; ++ks) acc[g][nt] = __builtin_amdgcn_mfma_f32_16x16x32_bf16(af[ks], bfr[g][nt][ks], acc[g][nt], 0, 0, 0); }
#pragma unroll
        for (int nt = 0; nt < 4; ++nt)
#pragma unroll
            for (int j = 0; j < 4; ++j) { const int tokl = 4 * fq + j, chl = nt * 16 + fr;
                const float rg = __builtin_amdgcn_rcpf(1.0f + __builtin_amdgcn_exp2f(-1.4426950408889634f * (acc[0][nt][j] + ba[nt]))), ig = __builtin_amdgcn_rcpf(1.0f + __builtin_amdgcn_exp2f(-1.4426950408889634f * (acc[1][nt][j] + bx[nt])));
                const float a = __builtin_amdgcn_exp2f(cl[nt] * rg);
                const float xv = __uint_as_float(((unsigned)*(const LAS unsigned short*)(xsl + (mt * 16 + tokl) * 144 + chl * 2)) << 16);
                const float bb = __builtin_amdgcn_sqrtf(fmaxf(1.0f - a * a, 0.f)) * (ig * xv);
                abl[tokl * 64 + chl] = (f32x2){a, bb}; }
        LDS_WAIT();
#pragma unroll
        for (int half = 0; half < 2; ++half) {
            const int hb = d == 0 ? half : 1 - half;
            f32x2 abv[8];
#pragma unroll
            for (int t = 0; t < 8; ++t) abv[t] = abl[(hb * 8 + t) * 64 + lane];
#pragma unroll
            for (int sidx = 0; sidx < 8; ++sidx) {
                const int t8 = d == 0 ? sidx : 7 - sidx, tokl = hb * 8 + t8, idx = mt * 16 + tokl;
                h = abv[t8].x * h + abv[t8].y; asm volatile("" : "+v"(h));
                if (!FINAL) aprod *= abv[t8].x;
                if (FINAL) {
                    bf16* yp = Y + (size_t)(m0 + idx) * D + cb * 64 + lane;
                    if (d == 0) *yp = f2bf(h);
                    else { const float gv = __uint_as_float(((unsigned)gt[tokl]) << 16), hfv = __uint_as_float(((unsigned)hq[tokl]) << 16); *yp = f2bf((hfv + h) * gelu_tanh_fast(gv)); } }
            }
        }
    }
    if (!FINAL) { float* ag = agg + ((size_t)line * 2 + d) * 2 * DLRU + cb * 64 + lane; ag[0] = aprod; ag[DLRU] = h; }
}
template <bool FINAL>
__device__ __forceinline__ void lru_unit(const In& in, const bf16* P, const bf16* WtL, int line, int cb, LAS unsigned char* wl, int lane, float* agg, const float* carry, bf16* Y) {
    int m0, pos0, len;
    if (line < 256) { m0 = (line >> 6) * SEQ + (line & 63) * GW; pos0 = 0; len = GW; } else { const int b = (line - 256) >> 2, q = (line - 256) & 3; m0 = T + b * CTXL + q * 64; pos0 = q * 64; len = CTXL; }
    LAS unsigned char* xsl = wl; LAS f32x2* abl = (LAS f32x2*)(wl + 9216);
    {
        const int cg = lane & 7, ch0 = cb * 64 + cg * 8;
        float cw[4][8], cbias[8];
#pragma unroll
        for (int tap = 0; tap < 4; ++tap) { const f32x4 w0 = *(const f32x4*)(in.conv_w + tap * DLRU + ch0), w1 = *(const f32x4*)(in.conv_w + tap * DLRU + ch0 + 4);
#pragma unroll
            for (int j = 0; j < 4; ++j) { cw[tap][j] = w0[j]; cw[tap][4 + j] = w1[j]; } }
        { const f32x4 b0 = *(const f32x4*)(in.conv_b + ch0), b1 = *(const f32x4*)(in.conv_b + ch0 + 4);
#pragma unroll
          for (int j = 0; j < 4; ++j) { cbias[j] = b0[j]; cbias[4 + j] = b1[j]; } }
#pragma unroll 1
        for (int ib = 0; ib < 2; ++ib) {
            u32x4 raw[4][4];
#pragma unroll
            for (int i4 = 0; i4 < 4; ++i4)
#pragma unroll
                for (int tap = 0; tap < 4; ++tap) { const int tok = (lane >> 3) + 8 * (ib * 4 + i4), q = pos0 + tok + tap - 2;
                    raw[i4][tap] = (u32x4){0u, 0u, 0u, 0u};
                    if (q >= 0 && q < len) raw[i4][tap] = *(const u32x4*)(P + (size_t)(m0 + tok + tap - 2) * PP + ch0); }
#pragma unroll
            for (int i4 = 0; i4 < 4; ++i4) { const int tok = (lane >> 3) + 8 * (ib * 4 + i4);
                float xs[8];
#pragma unroll
                for (int j = 0; j < 8; ++j) xs[j] = cbias[j];
#pragma unroll
                for (int tap = 0; tap < 4; ++tap) { float xv[8]; unpack8(raw[i4][tap], xv);
#pragma unroll
                    for (int j = 0; j < 8; ++j) xs[j] += cw[tap][j] * xv[j]; }
                *(LAS bf16x8*)(xsl + tok * 144 + cg * 16) = pack8(xs); }
        }
    }
    LDS_WAIT();
    lru_dir<FINAL, 0>(in, P, WtL, line, cb, m0, xsl, abl, lane, agg, carry, Y);
    lru_dir<FINAL, 1>(in, P, WtL, line, cb, m0, xsl, abl, lane, agg, carry, Y);
}

__device__ __forceinline__ int gla_row(int b, int n, int i) { return n < 4 ? T + b * CTXL + n * 64 + i : b * SEQ + (n - 4) * GW + i; }
__device__ __forceinline__ int gla_tok(int b, int n, int i) { return b * SEQ + i * GW + (n - 4); }
__device__ __forceinline__ float log_sigmoid_fast(float z) { return -(fmaxf(-z, 0.f) + __logf(1.0f + __expf(-fabsf(z)))); }
constexpr int GL_ALOW = 0, GL_WA = 4096, GL_BA = 12288, GL_LA = 12800  , GL_A = 47616  , GL_KD = 66048, GL_VT_P1 = 66048,
              GL_VT = 84480, GL_SC = 102912, GL_SS = 121344, GL_OT = 121856  , GL_END = 139264;
static_assert(GL_END <= SCR_BYTES, "gla scratch");
__device__ __forceinline__ void gla_decays(const In& in, const float* alow, int b, int h, int n, LAS unsigned char* lds, int tid) {
    LAS float* alowL = (LAS float*)(lds + GL_ALOW); LAS float* waL = (LAS float*)(lds + GL_WA); LAS float* baL = (LAS float*)(lds + GL_BA); LAS float* laL = (LAS float*)(lds + GL_LA);
    const int lane = tid & 63, wave = tid >> 6;
    if (tid < 256) { const int i = tid >> 2, part = tid & 3; *(LAS f32x4*)(alowL + i * 16 + part * 4) = *(const f32x4*)(alow + (size_t)gla_row(b, n, i) * RANK + part * 4); }
    { const int d = tid >> 8, r = (tid >> 4) & 15, c4 = (tid & 15) * 4; *(LAS f32x4*)(waL + (d * 16 + r) * 64 + c4) = *(const f32x4*)(in.gla_wa + ((size_t)d * RANK + r) * DGK + h * DK + c4); }
    if (tid < 128) baL[tid] = in.gla_ba[(tid >> 6) * DGK + h * DK + (tid & 63)];
    __syncthreads();
    { const int i = lane, k0 = wave * 8;
      float av[16];
#pragma unroll
      for (int r4 = 0; r4 < 4; ++r4) { const f32x4 t = *(const LAS f32x4*)(alowL + i * 16 + r4 * 4); av[r4 * 4] = t[0]; av[r4 * 4 + 1] = t[1]; av[r4 * 4 + 2] = t[2]; av[r4 * 4 + 3] = t[3]; }
#pragma unroll
      for (int d = 0; d < 2; ++d) { f32x4 z0 = *(const LAS f32x4*)(baL + d * 64 + k0), z1 = *(const LAS f32x4*)(baL + d * 64 + k0 + 4);
#pragma unroll
          for (int r = 0; r < RANK; ++r) { const f32x4 w0 = *(const LAS f32x4*)(waL + (d * 16 + r) * 64 + k0), w1 = *(const LAS f32x4*)(waL + (d * 16 + r) * 64 + k0 + 4); z0 += w0 * av[r]; z1 += w1 * av[r]; }
          f32x4 o0, o1;
#pragma unroll
          for (int j = 0; j < 4; ++j) { o0[j] = log_sigmoid_fast(z0[j]) * 0.0625f; o1[j] = log_sigmoid_fast(z1[j]) * 0.0625f; }
          *(LAS f32x4*)(laL + (d * 64 + i) * 68 + k0) = o0; *(LAS f32x4*)(laL + (d * 64 + i) * 68 + k0 + 4) = o1; } }
    __syncthreads();
    if (tid < 128) { const int d = tid >> 6, k = tid & 63; float v[64];
#pragma unroll
        for (int i = 0; i < 64; ++i) v[i] = laL[(d * 64 + i) * 68 + k];
        if (d == 0) {
#pragma unroll
            for (int i = 1; i < 64; ++i) v[i] += v[i - 1]; }
        else {
#pragma unroll
            for (int i = 62; i >= 0; --i) v[i] += v[i + 1]; }
#pragma unroll
        for (int i = 0; i < 64; ++i) laL[(d * 64 + i) * 68 + k] = v[i]; }
    __syncthreads();
}
__device__ __forceinline__ void gla_store_vT(const u32x4 r0, const u32x4 r1, LAS unsigned char* vt, int lane, int wave) {
    const unsigned w[8] = {r0.x, r0.y, r0.z, r0.w, r1.x, r1.y, r1.z, r1.w};
#pragma unroll
    for (int j = 0; j < 8; ++j) { *(LAS unsigned short*)(vt + ((wave * 16 + 2 * j) * 72 + lane) * 2) = (unsigned short)(w[j] & 0xffff); *(LAS unsigned short*)(vt + ((wave * 16 + 2 * j + 1) * 72 + lane) * 2) = (unsigned short)(w[j] >> 16); }
}
__device__ __forceinline__ void gla_pass1(const In& in, const bf16* P, const float* alow, int b, int h, int n, LAS unsigned char* lds, int tid, float* kvbuf, float* decbuf) {
    const int lane = tid & 63, w = __builtin_amdgcn_readfirstlane(tid >> 6), fr = lane & 15, fq = lane >> 4;
    const int uid = (b * HEADS + h) * 68 + n;
    const bf16* rp = P + (size_t)gla_row(b, n, lane) * PP;
    const u32x4 kraw = *(const u32x4*)(rp + 1280 + h * DK + w * 8), vr0 = *(const u32x4*)(rp + 1536 + h * DV + w * 16), vr1 = *(const u32x4*)(rp + 1536 + h * DV + w * 16 + 8);
    gla_decays(in, alow, b, h, n, lds, tid);
    LAS float* laL = (LAS float*)(lds + GL_LA);
    { const int i = lane, k0 = w * 8; float kv[8]; unpack8(kraw, kv);
#pragma unroll
      for (int d = 0; d < 2; ++d) { const int ie = d == 0 ? 63 : 0;
          const f32x4 bc0 = *(const LAS f32x4*)(laL + (d * 64 + i) * 68 + k0), bc1 = *(const LAS f32x4*)(laL + (d * 64 + i) * 68 + k0 + 4);
          const f32x4 bt0 = *(const LAS f32x4*)(laL + (d * 64 + ie) * 68 + k0), bt1 = *(const LAS f32x4*)(laL + (d * 64 + ie) * 68 + k0 + 4);
#pragma unroll
          for (int j = 0; j < 8; ++j) { const float bc = j < 4 ? bc0[j & 3] : bc1[j & 3], bt = j < 4 ? bt0[j & 3] : bt1[j & 3];
              *(LAS unsigned short*)(lds + GL_A + ((d * 64 + k0 + j) * 72 + i) * 2) = f2bf(kv[j] * __expf(bt - bc)); } } }
    gla_store_vT(vr0, vr1, lds + GL_VT_P1, lane, w);
    if (tid < 128) { const int d = tid >> 6, k = tid & 63; decbuf[((size_t)uid * 2 + d) * 64 + k] = __expf(laL[(d * 64 + (d == 0 ? 63 : 0)) * 68 + k]); }
    __syncthreads();
    { const int d = w >> 2, mt = w & 3;
      bf16x8 af[2];
#pragma unroll
      for (int ks = 0; ks < 2; ++ks) af[ks] = *(const LAS bf16x8*)(lds + GL_A + ((d * 64 + mt * 16 + fr) * 72 + ks * 32 + fq * 8) * 2);
#pragma unroll
      for (int nt = 0; nt < 8; ++nt) { f32x4 acc = (f32x4){0.f, 0.f, 0.f, 0.f};
#pragma unroll
          for (int ks = 0; ks < 2; ++ks) { const bf16x8 bfv = *(const LAS bf16x8*)(lds + GL_VT_P1 + ((nt * 16 + fr) * 72 + ks * 32 + fq * 8) * 2); acc = __builtin_amdgcn_mfma_f32_16x16x32_bf16(af[ks], bfv, acc, 0, 0, 0); }
          *(f32x4*)(kvbuf + (((size_t)uid * 2 + d) * DV + nt * 16 + fr) * DK + mt * 16 + 4 * fq) = acc; } }
    __syncthreads();
}
__device__ __forceinline__ void gla_final(const In& in, const bf16* P, const float* alow, int b, int h, int c, LAS unsigned char* lds, int tid, const bf16* Sbuf, bf16* Y) {
    const int lane = tid & 63, w = __builtin_amdgcn_readfirstlane(tid >> 6), fr = lane & 15, fq = lane >> 4, n = c + 4;
    const int uidL = (b * HEADS + h) * 64 + c;
    const bf16* rp = P + (size_t)gla_row(b, n, lane) * PP;
    const u32x4 qraw = *(const u32x4*)(rp + 1024 + h * DK + w * 8), kraw = *(const u32x4*)(rp + 1280 + h * DK + w * 8), vr0 = *(const u32x4*)(rp + 1536 + h * DV + w * 16), vr1 = *(const u32x4*)(rp + 1536 + h * DV + w * 16 + 8);
    const int oi = tid >> 3, opart = tid & 7; const size_t om = (size_t)gla_row(b, n, oi), otok = (size_t)gla_tok(b, n, oi);
    const u32x4 gr0 = *(const u32x4*)(P + om * PP + 2048 + h * DV + opart * 16), gr1 = *(const u32x4*)(P + om * PP + 2048 + h * DV + opart * 16 + 8);
    gla_decays(in, alow, b, h, n, lds, tid);
    LAS float* laL = (LAS float*)(lds + GL_LA);
    { const int i = lane, k0 = w * 8; float qv[8], kv[8]; unpack8(qraw, qv); unpack8(kraw, kv);
#pragma unroll
      for (int d = 0; d < 2; ++d) { float qd[8], kd[8];
          const f32x4 bc0 = *(const LAS f32x4*)(laL + (d * 64 + i) * 68 + k0), bc1 = *(const LAS f32x4*)(laL + (d * 64 + i) * 68 + k0 + 4);
#pragma unroll
          for (int j = 0; j < 8; ++j) { const float bc = j < 4 ? bc0[j & 3] : bc1[j & 3]; qd[j] = qv[j] * 0.125f * __expf(bc); kd[j] = kv[j] * __expf(-bc); }
          *(LAS bf16x8*)(lds + GL_A + ((d * 64 + i) * 72 + k0) * 2) = pack8(qd); *(LAS bf16x8*)(lds + GL_KD + ((d * 64 + i) * 72 + k0) * 2) = pack8(kd); } }
    gla_store_vT(vr0, vr1, lds + GL_VT, lane, w);
    __syncthreads();
    { const int d = w >> 2, mt = w & 3;
      bf16x8 af[2];
#pragma unroll
      for (int ks = 0; ks < 2; ++ks) af[ks] = *(const LAS bf16x8*)(lds + GL_A + ((d * 64 + mt * 16 + fr) * 72 + ks * 32 + fq * 8) * 2);
#pragma unroll
      for (int nt = 0; nt < 4; ++nt) { f32x4 acc = (f32x4){0.f, 0.f, 0.f, 0.f};
#pragma unroll
          for (int ks = 0; ks < 2; ++ks) { const bf16x8 bfv = *(const LAS bf16x8*)(lds + GL_KD + ((d * 64 + nt * 16 + fr) * 72 + ks * 32 + fq * 8) * 2); acc = __builtin_amdgcn_mfma_f32_16x16x32_bf16(af[ks], bfv, acc, 0, 0, 0); }
#pragma unroll
          for (int r = 0; r < 4; ++r) { const int i = mt * 16 + 4 * fq + r, j = nt * 16 + fr; const bool keep = d == 0 ? (j <= i) : (j >= i);
              *(LAS unsigned short*)(lds + GL_SC + ((d * 64 + i) * 72 + j) * 2) = f2bf(keep ? acc[r] : 0.f); } } }
    const int mt = w & 3, nh = w >> 2;
    bf16x8 sfr[2][2][4];
#pragma unroll
    for (int d = 0; d < 2; ++d)
#pragma unroll
        for (int ks = 0; ks < 2; ++ks)
#pragma unroll
            for (int q = 0; q < 4; ++q) sfr[d][ks][q] = *(const bf16x8*)(Sbuf + (((size_t)uidL * 2 + d) * DV + (nh * 4 + q) * 16 + fr) * DK + ks * 32 + fq * 8);
    __syncthreads();
    f32x4 acc[4];
#pragma unroll
    for (int q = 0; q < 4; ++q) acc[q] = (f32x4){0.f, 0.f, 0.f, 0.f};
#pragma unroll
    for (int d = 0; d < 2; ++d)
#pragma unroll
        for (int ks = 0; ks < 2; ++ks) {
            const bf16x8 a1 = *(const LAS bf16x8*)(lds + GL_SC + ((d * 64 + mt * 16 + fr) * 72 + ks * 32 + fq * 8) * 2);
            const bf16x8 a2 = *(const LAS bf16x8*)(lds + GL_A + ((d * 64 + mt * 16 + fr) * 72 + ks * 32 + fq * 8) * 2);
#pragma unroll
            for (int q = 0; q < 4; ++q) { const int nt = nh * 4 + q;
                const bf16x8 b1 = *(const LAS bf16x8*)(lds + GL_VT + ((nt * 16 + fr) * 72 + ks * 32 + fq * 8) * 2);
                acc[q] = __builtin_amdgcn_mfma_f32_16x16x32_bf16(a1, b1, acc[q], 0, 0, 0);
                acc[q] = __builtin_amdgcn_mfma_f32_16x16x32_bf16(a2, sfr[d][ks][q], acc[q], 0, 0, 0); } }
    LAS float* ssL = (LAS float*)(lds + GL_SS);
#pragma unroll
    for (int r = 0; r < 4; ++r) { float ss = 0.f;
#pragma unroll
        for (int q = 0; q < 4; ++q) ss += acc[q][r] * acc[q][r];
        ss += dppf<DPP_XOR1>(ss); ss += dppf<DPP_XOR2>(ss); ss += dppf<DPP_XOR7>(ss); ss += dppf<DPP_XOR15>(ss);
        if (fr == 0) ssL[nh * 64 + mt * 16 + 4 * fq + r] = ss; }
    __syncthreads();
#pragma unroll
    for (int r = 0; r < 4; ++r) { const int i = mt * 16 + 4 * fq + r; const float rs = rsqrtf((ssL[i] + ssL[64 + i]) * (1.0f / DV) + RMS_EPS);
#pragma unroll
        for (int q = 0; q < 4; ++q) *(LAS unsigned short*)(lds + GL_OT + (i * 136 + (nh * 4 + q) * 16 + fr) * 2) = f2bf(acc[q][r] * rs); }
    __syncthreads();
    { float ov[8], gv[8]; u32x4 o4[2];
#pragma unroll
      for (int half = 0; half < 2; ++half) { unpack8(*(const LAS u32x4*)(lds + GL_OT + (oi * 136 + opart * 16 + half * 8) * 2), ov); unpack8(half == 0 ? gr0 : gr1, gv);
          const int cc = h * DV + opart * 16 + half * 8; const f32x4 n0 = *(const f32x4*)(in.gla_norm_g + cc), n1 = *(const f32x4*)(in.gla_norm_g + cc + 4);
          float yv[8];
#pragma unroll
          for (int j = 0; j < 8; ++j) yv[j] = ov[j] * (j < 4 ? n0[j & 3] : n1[j & 3]) * (gv[j] * fast_sigmoid(gv[j]));
          o4[half] = __builtin_bit_cast(u32x4, pack8(yv)); }
      bf16* yp = Y + otok * D + DLRU + h * DV + opart * 16; *(u32x4*)yp = o4[0]; *(u32x4*)(yp + 8) = o4[1]; }
    __syncthreads();
}

#define XB_TMO      128
#define XB_XCNT(j)  (256  + 64 * (j))
#define XB_XSUB(j)  (1280 + 64 * (j))
#define XB_XGEN(j)  (2304 + 64 * (j))
#define XB_TOP      3328
#define XB_TOPGEN   3392
#define XCD_BAR_WORDS 3456
#define XB_SPIN_CAP (1u << 22)
constexpr int CW_BAR = 4096;
static_assert((CW_BAR + XCD_BAR_WORDS) * 4 <= (int)CTL_ZERO_BYTES, "barrier words inside the memset region");
__device__ __forceinline__ unsigned xb_ld(unsigned* p)              { return __hip_atomic_load(p, __ATOMIC_RELAXED, __HIP_MEMORY_SCOPE_AGENT); }
__device__ __forceinline__ unsigned xb_add(unsigned* p, unsigned v) { return __hip_atomic_fetch_add(p, v, __ATOMIC_RELAXED, __HIP_MEMORY_SCOPE_AGENT); }
__device__ __forceinline__ unsigned xb_xcc_id() { return (unsigned)__builtin_amdgcn_s_getreg((3 << 11) | 20) & 0xFu; }
#define XB_SPIN(cond, bar) do { unsigned _sp = 0; while (cond) { __builtin_amdgcn_s_sleep(1); \
    if ((++_sp & 255u) == 0u) { if (xb_ld(&(bar)[XB_TMO])) break; if (_sp > XB_SPIN_CAP) { atomicAdd(&(bar)[XB_TMO], 1u); break; } } } } while (0)
struct XcdBarrier { unsigned* bar; unsigned x; volatile LAS unsigned* st; };
__device__ __forceinline__ XcdBarrier xcd_barrier_post(unsigned* bar, volatile LAS unsigned* st) {
    XcdBarrier b; b.bar = bar; b.x = xb_xcc_id(); b.st = st;
    if (threadIdx.x == 0) (void)xb_add(&bar[XB_XCNT(b.x)], 1u);
    return b;
}
__device__ __forceinline__ void xcd_barrier_complete(unsigned* bar, unsigned x, unsigned& nloc, unsigned& nx) {
    const unsigned G = gridDim.x * gridDim.y * gridDim.z;
    unsigned sum, cnt, mine, sp = 0u;
    for (;;) {
        sum = 0u; cnt = 0u; mine = 0u;
#pragma unroll
        for (unsigned j = 0; j < 16; ++j) { const unsigned c = xb_ld(&bar[XB_XCNT(j)]); sum += c; cnt += (c > 0u) ? 1u : 0u; mine = (j == x) ? c : mine; }
        if (sum == G) break;
        __builtin_amdgcn_s_sleep(1);
        if ((++sp & 255u) == 0u) { if (xb_ld(&bar[XB_TMO])) break; if (sp > XB_SPIN_CAP) { atomicAdd(&bar[XB_TMO], 1u); break; } }
    }
    nloc = mine > 0u ? mine : 1u; nx = cnt > 0u ? cnt : 1u;
}
__device__ __forceinline__ void xcd_barrier(const XcdBarrier& b) {
    asm volatile("s_waitcnt vmcnt(0)" ::: "memory");
    __syncthreads();
    if (threadIdx.x == 0) {
        unsigned* bar = b.bar;
        __builtin_amdgcn_s_waitcnt(0);
        unsigned nloc = b.st[0], nx = b.st[1];
        if (nloc == 0u) { xcd_barrier_complete(bar, b.x, nloc, nx); b.st[0] = nloc; b.st[1] = nx; }
        const unsigned old = xb_add(&bar[XB_XSUB(b.x)], 1u);
        const unsigned gen = old / nloc;
        if (old + 1u == (gen + 1u) * nloc) {
            __builtin_amdgcn_fence(__ATOMIC_RELEASE, "agent");
            asm volatile("s_waitcnt vmcnt(0)" ::: "memory");
            const unsigned og = xb_add(&bar[XB_TOP], 1u);
            const unsigned tg = og / nx;
            if (og + 1u == (tg + 1u) * nx) xb_add(&bar[XB_TOPGEN], 1u);
            else XB_SPIN(xb_ld(&bar[XB_TOPGEN]) == tg, bar);
            __builtin_amdgcn_fence(__ATOMIC_ACQUIRE, "agent");
            xb_add(&bar[XB_XGEN(b.x)], 1u);
            asm volatile("s_waitcnt vmcnt(0)" ::: "memory");
        } else {
            XB_SPIN(xb_ld(&bar[XB_XGEN(b.x)]) == gen, bar);
            __builtin_amdgcn_fence(__ATOMIC_ACQUIRE, "agent");
            asm volatile("s_waitcnt vmcnt(0)" ::: "memory");
        }
    }
    __syncthreads();
}

__device__ __forceinline__ void ada_item(const In& in, float* mod, int item, LAS unsigned char* lds, int tid) {
    LAS float* sv = (LAS float*)lds; LAS float* red = (LAS float*)(lds + 20480);
    const int lane = tid & 63, wave = tid >> 6;
    for (int idx = tid; idx < 5 * D; idx += NTHR) { const int r = idx >> 10, k = idx & 1023; const float cv = r < 4 ? in.c[r * D + k] : in.c_ctx[k]; sv[idx] = cv * fast_sigmoid(cv); }
    __syncthreads();
    const int n0 = item * 32, col = lane & 31, kpar = lane >> 5;
    float acc[5] = {0.f, 0.f, 0.f, 0.f, 0.f};
#pragma unroll 16
    for (int i = 0; i < 64; ++i) { const int k = wave * 128 + 2 * i + kpar; const float w = in.w_ada[(size_t)k * 6144 + n0 + col];
#pragma unroll
        for (int r = 0; r < 5; ++r) acc[r] += sv[r * D + k] * w; }
#pragma unroll
    for (int r = 0; r < 5; ++r) red[((wave * 2 + kpar) * 5 + r) * 32 + col] = acc[r];
    __syncthreads();
    if (tid < 160) { const int r = tid >> 5, c2 = tid & 31; float sum = 0.f;
#pragma unroll
        for (int p = 0; p < 16; ++p) sum += red[(p * 5 + r) * 32 + c2];
        mod[r * 6144 + n0 + c2] = sum + in.b_ada[n0 + c2]; }
    __syncthreads();
}
template <int NR>
__device__ __forceinline__ void mod_rows(const float* xr, const float* md, bf16* up, int lane) {
    f32x4 sh[4], sc[4], xv[NR][4];
#pragma unroll
    for (int r = 0; r < NR; ++r)
#pragma unroll
        for (int j = 0; j < 4; ++j) xv[r][j] = __builtin_nontemporal_load((const f32x4*)(xr + (size_t)r * D + 4 * lane + 256 * j));
#pragma unroll
    for (int j = 0; j < 4; ++j) { sh[j] = *(const f32x4*)(md + 4 * lane + 256 * j); sc[j] = *(const f32x4*)(md + 1024 + 4 * lane + 256 * j) + 1.0f; }
#pragma unroll
    for (int r = 0; r < NR; ++r)
#pragma unroll
        for (int j = 0; j < 4; ++j) { const f32x4 uv = xv[r][j] * sc[j] + sh[j]; u32x2 o; o.x = pk2(uv[0], uv[1]); o.y = pk2(uv[2], uv[3]); *(u32x2*)(up + (size_t)r * D + 4 * lane + 256 * j) = o; }
}
__device__ __forceinline__ void final_rows(const In& in, const bf16* z, float* zo, const float* mod, const unsigned char* ybuf, int m0, int mstep, int lane) {
    f32x4 l1g[4], l1b[4], l2g[4], l2b[4]; u32x2 zr[4]; unsigned yr[4][4];
#pragma unroll
    for (int j = 0; j < 4; ++j) { const int k = 4 * lane + 256 * j; l1g[j] = *(const f32x4*)(in.ln1_g + k); l1b[j] = *(const f32x4*)(in.ln1_b + k); l2g[j] = *(const f32x4*)(in.ln2_g + k); l2b[j] = *(const f32x4*)(in.ln2_b + k); }
#pragma unroll
    for (int j = 0; j < 4; ++j) { zr[j] = *(const u32x2*)(z + (size_t)m0 * pg8::ZP + 4 * lane + 256 * j);
#pragma unroll
        for (int t = 0; t < 4; ++t) yr[j][t] = __builtin_nontemporal_load((const unsigned*)(ybuf + ((size_t)m0 * 4 + t) * D + 4 * lane + 256 * j)); }
#pragma unroll 1
    for (int m = m0; m < T; m += mstep) {
        const int mn = (m + mstep < T) ? m + mstep : m;
        u32x2 zn[4]; unsigned yn[4][4]; f32x4 gg[4], v[4];
        const float* g2 = mod + (m / SEQ) * 6144 + 5120;
#pragma unroll
        for (int j = 0; j < 4; ++j) { zn[j] = *(const u32x2*)(z + (size_t)mn * pg8::ZP + 4 * lane + 256 * j);
#pragma unroll
            for (int t = 0; t < 4; ++t) yn[j][t] = __builtin_nontemporal_load((const unsigned*)(ybuf + ((size_t)mn * 4 + t) * D + 4 * lane + 256 * j));
            gg[j] = *(const f32x4*)(g2 + 4 * lane + 256 * j); }
        float s = 0.f;
#pragma unroll
        for (int j = 0; j < 4; ++j) { v[j] = (f32x4){__uint_as_float(zr[j].x << 16), __uint_as_float(zr[j].x & 0xffff0000u), __uint_as_float(zr[j].y << 16), __uint_as_float(zr[j].y & 0xffff0000u)}; s += (v[j][0] + v[j][1]) + (v[j][2] + v[j][3]); }
        float mean = wave_sum(s) * (1.0f / D), q = 0.f;
#pragma unroll
        for (int j = 0; j < 4; ++j) { v[j] = v[j] - mean; q += (v[j][0] * v[j][0] + v[j][1] * v[j][1]) + (v[j][2] * v[j][2] + v[j][3] * v[j][3]); }
        float rstd = rsqrtf(wave_sum(q) * (1.0f / D) + LN_EPS);
        s = 0.f;
#pragma unroll
        for (int j = 0; j < 4; ++j) { const f32x4 x1 = v[j] * rstd * l1g[j] + l1b[j];
            f32x4 mo = (f32x4){0.f, 0.f, 0.f, 0.f};
#pragma unroll
            for (int t = 0; t < 4; ++t) { const f32x2 lo = __builtin_amdgcn_cvt_pk_f32_fp8((int)yr[j][t], false), hi = __builtin_amdgcn_cvt_pk_f32_fp8((int)yr[j][t], true);
                mo[0] += lo[0]; mo[1] += lo[1]; mo[2] += hi[0]; mo[3] += hi[1]; }
            v[j] = x1 * ALPHA + gg[j] * (mo * (1.0f / pg8::YSCALE)); s += (v[j][0] + v[j][1]) + (v[j][2] + v[j][3]); }
        mean = wave_sum(s) * (1.0f / D); q = 0.f;
#pragma unroll
        for (int j = 0; j < 4; ++j) { v[j] = v[j] - mean; q += (v[j][0] * v[j][0] + v[j][1] * v[j][1]) + (v[j][2] * v[j][2] + v[j][3] * v[j][3]); }
        rstd = rsqrtf(wave_sum(q) * (1.0f / D) + LN_EPS);
#pragma unroll
        for (int j = 0; j < 4; ++j) { *(f32x4*)(zo + (size_t)m * D + 4 * lane + 256 * j) = v[j] * rstd * l2g[j] + l2b[j]; zr[j] = zn[j];
#pragma unroll
            for (int t = 0; t < 4; ++t) yr[j][t] = yn[j][t]; }
    }
}
constexpr int RT_PITCH = 1024, RT_W = 0, RT_GB = 131072  , RT_TAB = LDSTOK_OFF, RT_LCNT = RT_TAB + 64 * 4 * 8  , RT_BASE = RT_LCNT + 128;
static_assert(RT_GB + 8192 <= SCR_BYTES && RT_BASE + 128 <= LDS_BYTES, "route scratch");
__device__ __forceinline__ void route_stage_w(const In& in, LAS unsigned char* lds, int tid) {
    LAS float* wT = (LAS float*)(lds + RT_W);
    for (int idx = tid; idx < D * NE / 4; idx += NTHR) { const int k = idx >> 3, e0 = (idx & 7) * 4; const f32x4 w = *(const f32x4*)(in.w_router + (size_t)k * NE + e0);
#pragma unroll
        for (int j = 0; j < 4; ++j) wT[(e0 + j) * RT_PITCH + k] = w[j]; }
}
__device__ __forceinline__ void route_tile(const In& in, const bf16* z, const float* mod, unsigned char* H, float* tok_w, int* cnt, int* list, int tile, LAS unsigned char* lds, int tid) {
    const int lane = tid & 63, wave = tid >> 6;
    LAS float* wT = (LAS float*)(lds + RT_W); LAS float* GB = (LAS float*)(lds + RT_GB); LAS int* tab = (LAS int*)(lds + RT_TAB); LAS int* lcnt = (LAS int*)(lds + RT_LCNT); LAS int* gbase = (LAS int*)(lds + RT_BASE);
    if (tid < NE) lcnt[tid] = 0;
    if (tid < 256) { const float* md0 = mod + ((tile * 64) / SEQ) * 6144; const int k = tid * 4; const f32x4 g = *(const f32x4*)(in.ln1_g + k), b = *(const f32x4*)(in.ln1_b + k), sc = *(const f32x4*)(md0 + 4096 + k) + 1.0f, sh = *(const f32x4*)(md0 + 3072 + k);
        *(LAS f32x4*)(GB + k) = g * sc; *(LAS f32x4*)(GB + D + k) = b * sc + sh; }
    __syncthreads();
    u32x2 zr[4];
#pragma unroll
    for (int j = 0; j < 4; ++j) zr[j] = *(const u32x2*)(z + (size_t)(tile * 64 + wave * 8) * pg8::ZP + 4 * lane + 256 * j);
#pragma unroll 1
    for (int r = 0; r < 8; ++r) {
        const int rl = wave * 8 + r, m = tile * 64 + rl;
        f32x4 v[4]; float s = 0.f; u32x2 zn[4];
#pragma unroll
        for (int j = 0; j < 4; ++j) zn[j] = *(const u32x2*)(z + (size_t)(m + (r < 7 ? 1 : 0)) * pg8::ZP + 4 * lane + 256 * j);
#pragma unroll
        for (int j = 0; j < 4; ++j) { const u32x2 raw = zr[j]; v[j] = (f32x4){__uint_as_float(raw.x << 16), __uint_as_float(raw.x & 0xffff0000u), __uint_as_float(raw.y << 16), __uint_as_float(raw.y & 0xffff0000u)};
            s += (v[j][0] + v[j][1]) + (v[j][2] + v[j][3]); }
        const float mean = wave_sum(s) * (1.0f / D); float q = 0.f;
#pragma unroll
        for (int j = 0; j < 4; ++j) { v[j] = v[j] - mean; q += (v[j][0] * v[j][0] + v[j][1] * v[j][1]) + (v[j][2] * v[j][2] + v[j][3] * v[j][3]); }
        const float rstd = rsqrtf(wave_sum(q) * (1.0f / D) + LN_EPS);
#pragma unroll
        for (int j = 0; j < 4; ++j) { const int k = 4 * lane + 256 * j; v[j] = v[j] * rstd * *(const LAS f32x4*)(GB + k) + *(const LAS f32x4*)(GB + D + k);
            unsigned o = 0u; o = __builtin_amdgcn_cvt_pk_fp8_f32(v[j][0], v[j][1], o, false); o = __builtin_amdgcn_cvt_pk_fp8_f32(v[j][2], v[j][3], o, true); *(unsigned*)(H + (size_t)m * D + k) = o; }
        float lg[NE];
#pragma unroll
        for (int e = 0; e < NE; ++e) { float p = 0.f;
#pragma unroll
            for (int j = 0; j < 4; ++j) { const f32x4 w = *(const LAS f32x4*)(wT + e * RT_PITCH + 4 * lane + 256 * j); p += (v[j][0] * w[0] + v[j][1] * w[1]) + (v[j][2] * w[2] + v[j][3] * w[3]); }
            lg[e] = p; }
        float v16[16], v8[8], v4[4], v2[2];
#pragma unroll
        for (int e = 0; e < 16; ++e) { const auto r = __builtin_amdgcn_permlane32_swap(__float_as_uint(lg[e]), __float_as_uint(lg[e + 16]), false, false); v16[e] = __uint_as_float(r[0]) + __uint_as_float(r[1]); }
#pragma unroll
        for (int e = 0; e < 8; ++e) { const auto r = __builtin_amdgcn_permlane16_swap(__float_as_uint(v16[e]), __float_as_uint(v16[e + 8]), false, false); v8[e] = __uint_as_float(r[0]) + __uint_as_float(r[1]); }
#pragma unroll
        for (int e = 0; e < 4; ++e) { const bool hi = lane & 8; const float keep = hi ? v8[e + 4] : v8[e], send = hi ? v8[e] : v8[e + 4]; v4[e] = keep + dppf<DPP_XOR15>(send); }
#pragma unroll
        for (int e = 0; e < 2; ++e) { const bool hi = lane & 4; const float keep = hi ? v4[e + 2] : v4[e], send = hi ? v4[e] : v4[e + 2]; v2[e] = keep + dppf<DPP_XOR7>(send); }
        float val; { const bool hi = lane & 2; const float keep = hi ? v2[1] : v2[0], send = hi ? v2[0] : v2[1]; val = keep + dppf<DPP_XOR2>(send); }
        val += dppf<DPP_XOR1>(val);
        const int me = lane >> 1; val += in.b_router[me];
        int ei[4]; float ev[4];
#pragma unroll
        for (int j = 0; j < 4; ++j) { const float mx = wave_max(val);
            const unsigned long long bal = __ballot(val == mx); const int wl = __builtin_ctzll(bal); ei[j] = wl >> 1; ev[j] = mx; if (me == ei[j]) val = -3.0e38f; }
        float wsum = 0.f, wj[4];
#pragma unroll
        for (int j = 0; j < 4; ++j) { wj[j] = __expf(ev[j] - ev[0]); wsum += wj[j]; }
        const float inv = 1.0f / wsum;
        if (lane < 4) { const int e = lane == 0 ? ei[0] : lane == 1 ? ei[1] : lane == 2 ? ei[2] : ei[3]; const float w = (lane == 0 ? wj[0] : lane == 1 ? wj[1] : lane == 2 ? wj[2] : wj[3]) * inv;
            const int rank = __hip_atomic_fetch_add(&lcnt[e], 1, __ATOMIC_RELAXED, __HIP_MEMORY_SCOPE_WORKGROUP); tab[(rl * 4 + lane) * 2] = e; tab[(rl * 4 + lane) * 2 + 1] = rank; tok_w[(size_t)m * 4 + lane] = w; }
#pragma unroll
        for (int j = 0; j < 4; ++j) zr[j] = zn[j];
    }
    __syncthreads();
    if (tid < NE) gbase[tid] = atomicAdd(&cnt[tid], lcnt[tid]);
    __syncthreads();
    if (tid < 256) { const int e = tab[tid * 2], rank = tab[tid * 2 + 1]; list[(size_t)e * T + gbase[e] + rank] = (tile * 64 + (tid >> 2)) * 4 + (tid & 3); }
    __syncthreads();
}

__global__ void __launch_bounds__(NTHR, 2) mega(Args args) {
    extern __shared__ __attribute__((aligned(16))) unsigned char lds_raw[];
    LAS unsigned char* lds = (LAS unsigned char*)lds_raw;
    const In& in = args.in; unsigned char* ws = args.ws;
    const int tid = threadIdx.x, lane = tid & 63, wave = __builtin_amdgcn_readfirstlane(tid >> 6);
    const int G = gridDim.x, bx = blockIdx.x;
    const int vcu = (G % 8 == 0) ? (bx % 8) * (G / 8) + bx / 8 : bx;
    const int gw = vcu * NWAVES + wave, NGW = G * NWAVES;
    const unsigned ph = args.phases;
    for (int u = tid; u < 128; u += NTHR) ((LAS unsigned*)(lds + LDSCTL_OFF))[u] = 0u;
    __syncthreads();
    XcdBarrier bar; bar.bar = (unsigned*)(ws + WS_CTL) + CW_BAR; bar.x = 0; bar.st = nullptr;
    if (ph & (ph - 1)) bar = xcd_barrier_post((unsigned*)(ws + WS_CTL) + CW_BAR, (volatile LAS unsigned*)(lds + LDSCTL_OFF) + 8);
#define PHASE_END(p) do { if (ph >> ((p) + 1)) xcd_barrier(bar); } while (0)
    bf16* WtIn = (bf16*)(ws + WS_WTIN); bf16* WtOut = (bf16*)(ws + WS_WTOUT); unsigned char* WGU = ws + WS_WGU; unsigned char* WDN = ws + WS_WDN; bf16* WtL = (bf16*)(ws + WS_WTL);
    bf16* U = (bf16*)(ws + WS_U); bf16* P = (bf16*)(ws + WS_P); float* alow = (float*)(ws + WS_ALOW); bf16* Y = (bf16*)(ws + WS_Y); unsigned char* H = ws + WS_H;
    unsigned char* ACT = ws + WS_ACT; unsigned char* YBUF = ws + WS_YBUF; float* mod = (float*)(ws + WS_MOD);
    const int* cnt = (const int*)(ws + WS_CTL); const int* list = (const int*)(ws + WS_LIST); const float* tok_w = (const float*)(ws + WS_ROUTE_W);
    LAS int* tb = (LAS int*)(lds + LDSTBL_OFF); LAS int* cntl = tb + 40;
    float* agg = (float*)(ws + WS_AGG); float* carry = (float*)(ws + WS_CARRY); float* decbuf = (float*)(ws + WS_DEC); float* kvbuf = (float*)(ws + WS_KV);
    bf16* Sbuf = (bf16*)args.out;

    if (ph & (1u << PH_SMALLW)) {
        for (int it = bx; it < 192; it += G) ada_item(in, mod, it, lds, tid);
        LAS float* scr = (LAS float*)(lds + wave * 16384);
        constexpr int I_IN = 16 * 81, I_OUT = 16 * 32;
        for (int it = gw; it < I_IN + I_OUT; it += NGW) {
            if (it < I_IN) { const int kb = it / 81, nb = it % 81, n0 = nb * 32; tr_item(in.w_in, DIN, kb * 64, n0, (DIN - n0) < 32 ? (DIN - n0) : 32, WtIn + (size_t)n0 * D, D, scr, lane); }
            else { const int r = it - I_IN, kb = r / 32, nb = r % 32; tr_item(in.w_out, D, kb * 64, nb * 32, 32, WtOut + (size_t)(nb * 32) * D, D, scr, lane); }
        }
        for (int i = bx * NTHR + tid; i < (NIN - DIN) * D / 8; i += G * NTHR) *(u32x4*)(WtIn + (size_t)DIN * D + (size_t)i * 8) = (u32x4){0u, 0u, 0u, 0u};
        for (int i = bx * NTHR + tid; i < 2 * 2 * 8 * 64 * 64; i += G * NTHR) {
            const int c = i & 63, o = (i >> 6) & 63, blk = (i >> 12) & 7, gsel = (i >> 15) & 1, d = i >> 16;
            const float* src = gsel ? in.lru_wx : in.lru_wa;
            WtL[i] = f2bf(src[((size_t)(d * 8 + blk) * 64 + c) * 64 + o]); }
    }
    if (ph & (1u << PH_WEXP)) {
        LAS float* scr = (LAS float*)(lds + wave * 16384);
        for (int it = gw; it < 96 * 512; it += NGW) {
            const int mi = it >> 9, r = it & 511, kb = r >> 5, nb = r & 31, n0 = nb * 32, type = mi >> 5, e = mi & 31;
            const float* W; unsigned char* dst;
            if (type == 0) { W = in.w_gate + (size_t)e * D * D; dst = WGU + ((size_t)e * 2048 + (n0 >> 7) * 256 + (n0 & 127)) * D; }
            else if (type == 1) { W = in.w_up + (size_t)e * D * D; dst = WGU + ((size_t)e * 2048 + (n0 >> 7) * 256 + 128 + (n0 & 127)) * D; }
            else { W = in.w_down + (size_t)e * D * D; dst = WDN + ((size_t)e * D + n0) * D; }
            tr_item8(W, D, kb * 64, n0, dst, D, scr, lane);
        }
    }
    if (ph & 3u) PHASE_END(PH_WEXP);
    if (ph & (1u << PH_MOD)) {
        for (int r0 = gw * 4; r0 < T; r0 += NGW * 4) mod_rows<4>(in.x + (size_t)r0 * D, mod + (r0 / SEQ) * 6144, U + (size_t)r0 * D, lane);
        for (int r0 = gw; r0 < TC; r0 += NGW) mod_rows<1>(in.ctx + (size_t)r0 * D, mod + 4 * 6144, U + (size_t)(T + r0) * D, lane);
        PHASE_END(PH_MOD);
    }
    if (ph & (1u << PH_INPROJ)) {
        pg8::Gemm g{U, WtIn, D * 2}; pg8::StaticOrder S; S.init(MR, NIN, D * 2, G, bx);
        pg8::EpiInProj E{P, alow};
        pg8::gemm_phase<pg8::EpiInProj, pg8::StaticOrder, true, false>(lds, g, S, E);
        PHASE_END(PH_INPROJ);
    }
    if (ph & (1u << PH_MIX1)) {
#ifndef MK_REP
#define MK_REP 0
#endif
        for (int rep = 0; rep < ((MK_REP & 1) ? 2 : 1); ++rep)
        for (int u = vcu; u < BATCH * HEADS * 68; u += G) { const int n = u % 68, bh = u / 68; gla_pass1(in, P, alow, bh >> 2, bh & 3, n, lds, tid, kvbuf, decbuf); }
        for (int rep = 0; rep < ((MK_REP & 2) ? 2 : 1); ++rep)
        if (G == 256) {
            lru_unit<false>(in, P, WtL, gw >> 3, gw & 7, lds + wave * LRU_WAVE_LDS, lane, agg, carry, Y);
            const int u2 = 2048 + (vcu - 64);
            if (vcu >= 64 && wave == 0 && u2 < 272 * 8) lru_unit<false>(in, P, WtL, u2 >> 3, u2 & 7, lds + wave * LRU_WAVE_LDS, lane, agg, carry, Y);
        } else for (int u = gw; u < 272 * 8; u += NGW) lru_unit<false>(in, P, WtL, u >> 3, u & 7, lds + wave * LRU_WAVE_LDS, lane, agg, carry, Y);
        PHASE_END(PH_MIX1);
    }
    if (ph & (1u << PH_MIX2)) {
        { const int gid = bx * NTHR + tid;
          const int combo = gid >> 12, pr = gid & 4095, dv = pr >> 5, dk = (pr & 31) * 2, d = combo & 1, bh = combo >> 1;
          if (combo < BATCH * HEADS * 2) { f32x2 S = (f32x2){0.f, 0.f};
              const float* kvp = kvbuf + (((size_t)bh * 68 * 2 + d) * DV + dv) * DK + dk; const float* dcp = decbuf + ((size_t)bh * 68 * 2 + d) * 64 + dk;
              bf16* sp = Sbuf + ((((size_t)bh * 64) * 2 + d) * DV + dv) * DK + dk;
#pragma unroll 1
              for (int s0 = 0; s0 < 68; s0 += 17) { f32x2 kvv[17], dcv[17];
#pragma unroll
                  for (int j = 0; j < 17; ++j) { const int st = s0 + j, n = d == 0 ? st : (st < 4 ? 3 - st : 71 - st); kvv[j] = *(const f32x2*)(kvp + (size_t)n * (2 * DV * DK)); dcv[j] = *(const f32x2*)(dcp + n * 128); }
#pragma unroll
                  for (int j = 0; j < 17; ++j) { const int st = s0 + j, n = d == 0 ? st : (st < 4 ? 3 - st : 71 - st);
                      if (n >= 4) *(unsigned*)(sp + (size_t)(n - 4) * (2 * DV * DK)) = pk2(S.x, S.y);
                      S = dcv[j] * S + kvv[j]; } } } }
        { const int gid = bx * NTHR + tid;
          if (gid < BATCH * 2 * DLRU) { const int ch = gid & 511, d = (gid >> 9) & 1, b = gid >> 10; float h = 0.f;
#pragma unroll 1
              for (int s0 = 0; s0 < 68; s0 += 17) { float av[17], bv[17];
#pragma unroll
                  for (int j = 0; j < 17; ++j) { const int st = s0 + j; int line; if (st < 4) line = 256 + b * 4 + (d == 0 ? st : 3 - st); else line = b * 64 + (d == 0 ? st - 4 : 67 - st);
                      const float* ag = agg + ((size_t)line * 2 + d) * 2 * DLRU + ch; av[j] = ag[0]; bv[j] = ag[DLRU]; }
#pragma unroll
                  for (int j = 0; j < 17; ++j) { const int st = s0 + j; int line; if (st < 4) line = 256 + b * 4 + (d == 0 ? st : 3 - st); else line = b * 64 + (d == 0 ? st - 4 : 67 - st);
                      if (line < 256) carry[((size_t)line * 2 + d) * DLRU + ch] = h;
                      h = av[j] * h + bv[j]; asm volatile("" : "+v"(h)); } } } }
        PHASE_END(PH_MIX2);
    }
    if (ph & (1u << PH_MIX3)) {
        for (int rep = 0; rep < ((MK_REP & 4) ? 2 : 1); ++rep)
        for (int u = vcu; u < BATCH * HEADS * 64; u += G) { const int c = u & 63, bh = u >> 6; gla_final(in, P, alow, bh >> 2, bh & 3, c, lds, tid, Sbuf, Y); }
        for (int rep = 0; rep < ((MK_REP & 8) ? 2 : 1); ++rep)
        for (int u = gw; u < 256 * 8; u += NGW) lru_unit<true>(in, P, WtL, u >> 3, u & 7, lds + wave * LRU_WAVE_LDS, lane, agg, carry, Y);
        PHASE_END(PH_MIX3);
    }
    if (ph & (1u << PH_OUTPROJ)) {
        pg8::Gemm g{Y, WtOut, D * 2}; pg8::StaticOrder S; S.init(T, D, D * 2, G, bx);
        pg8::EpiOutProj E{in.x, mod, (bf16*)(ws + WS_Z)};
        pg8::gemm_phase<pg8::EpiOutProj, pg8::StaticOrder, true, false>(lds, g, S, E);
        PHASE_END(PH_OUTPROJ);
    }
    if (ph & (1u << PH_ROUTE)) {
        route_stage_w(in, lds, tid);
        __syncthreads();
        for (int tile = vcu; tile < T / 64; tile += G) route_tile(in, (const bf16*)(ws + WS_Z), mod, H, (float*)(ws + WS_ROUTE_W), (int*)(ws + WS_CTL), (int*)(ws + WS_LIST), tile, lds, tid);
        PHASE_END(PH_ROUTE);
    }
    LAS int* utab = (LAS int*)(lds + LDSTBL_OFF + 320); LAS int* nuL = utab + 4 * MAXU_GU;
    if (ph & ((1u << PH_GU) | (1u << PH_DOWN))) {
        if (tid < 64) {
            const int c = lane < NE ? cnt[lane] : 0; int incl = (c + 127) >> 7;
#pragma unroll
            for (int o = 1; o < 32; o <<= 1) { const int t = __shfl_up(incl, o); if ((lane & 31) >= o) incl += t; }
            if (lane < NE) { cntl[lane] = c; tb[lane] = incl - ((c + 127) >> 7); if (lane == NE - 1) tb[NE] = incl; }
        }
        __syncthreads();
    }
    if (ph & (1u << PH_GU)) {
        LAS unsigned* tok = (LAS unsigned*)(lds + LDSTOK_OFF);
        pg8::moe_unit_table(tb, utab, nuL, 8, G, bx, MAXU_GU, tid);
        __syncthreads();
        pg8::MoeOrder8 S{utab, tok, nuL[0], D, 1};
        for (int idx = tid; idx < S.nu * 128; idx += NTHR) { const int i = idx >> 7, r = idx & 127, e = utab[4 * i + 2]; const int slot = (utab[4 * i] - tb[e]) * 128 + r;
            tok[idx] = slot < cntl[e] ? (unsigned)(list[(size_t)e * T + slot] >> 2) * (unsigned)D : 0u; }
        __syncthreads();
        pg8::Gemm g{H, WGU, D};
        pg8::EpiGU8 E{in.b_gate, in.b_up, ACT};
        pg8::gemm_phase8<pg8::EpiGU8>(lds, g, S, E);
        PHASE_END(PH_GU);
    }
    if (ph & (1u << PH_DOWN)) {
        LAS int* dtab = (LAS int*)(lds + LDSTOK_OFF); LAS float* wtab = (LAS float*)(lds + LDSTOK_OFF + MAXU_DN * 512);
        pg8::moe_unit_table(tb, utab, nuL, 4, G, bx, MAXU_DN, tid);
        __syncthreads();
        pg8::MoeOrder8 S{utab, nullptr, nuL[0], D, 0};
        for (int idx = tid; idx < S.nu * 128; idx += NTHR) { const int i = idx >> 7, r = idx & 127, e = utab[4 * i + 2]; const int slot = (utab[4 * i] - tb[e]) * 128 + r; int dest = -1; float wg = 0.f;
            if (slot < cntl[e]) { dest = list[(size_t)e * T + slot]; wg = tok_w[dest]; } dtab[idx] = dest; wtab[idx] = wg; }
        __syncthreads();
        pg8::Gemm g{ACT, WDN, D};
        pg8::EpiDown8 E{in.b_down, YBUF, dtab, wtab};
        pg8::gemm_phase8<pg8::EpiDown8>(lds, g, S, E);
        PHASE_END(PH_DOWN);
    }
    if (ph & (1u << PH_FINAL)) { if (gw < T) final_rows(in, (const bf16*)(ws + WS_Z), args.out, mod, YBUF, gw, NGW, lane); }
#undef PHASE_END
}

static int g_grid = 0;
static void launch_mega(const Args& a0, unsigned phases, hipStream_t stream) {
    Args a = a0; a.phases = phases;
    hipLaunchKernelGGL(mega, dim3(g_grid), dim3(NTHR), LDS_BYTES, stream, a);
}

extern "C" void kernel_launch(void* const* d_in, const int* in_sizes, int n_in, void* d_out, int out_size, void* d_ws, size_t ws_size, hipStream_t stream) {
    if (n_in != 30 || ws_size < WS_END) { fprintf(stderr, "kernel_launch: unexpected n_in %d or ws_size %zu (< %zu)\n", n_in, ws_size, (size_t)WS_END); return; }
    if (g_grid == 0) {
        int dev = 0, cus = 0, per_cu = 0;
        if (hipGetDevice(&dev) != hipSuccess || hipDeviceGetAttribute(&cus, hipDeviceAttributeMultiprocessorCount, dev) != hipSuccess) { fprintf(stderr, "kernel_launch: device query failed\n"); g_grid = -1; return; }
        if (hipFuncSetAttribute((const void*)mega, hipFuncAttributeMaxDynamicSharedMemorySize, LDS_BYTES) != hipSuccess) { fprintf(stderr, "kernel_launch: hipFuncSetAttribute failed\n"); g_grid = -1; return; }
        if (hipOccupancyMaxActiveBlocksPerMultiprocessor(&per_cu, (const void*)mega, NTHR, LDS_BYTES) != hipSuccess || per_cu < 1) { fprintf(stderr, "kernel_launch: occupancy query says %d blocks/CU\n", per_cu); g_grid = -1; return; }
        (void)hipGetLastError();
        g_grid = cus;
    }
    if (g_grid < 0) return;
    Args a{};
    const float** ip = (const float**)&a.in;
    for (int i = 0; i < 30; ++i) ip[i] = (const float*)d_in[i];
    a.out = (float*)d_out; a.ws = (unsigned char*)d_ws;
    unsigned char* ws = (unsigned char*)d_ws;
    (void)hipMemsetAsync(ws + WS_CTL, 0, CTL_ZERO_BYTES, stream);
#ifndef MK_PER_PHASE
#define MK_PER_PHASE 0
#endif
    const unsigned all = (1u << PH_SMALLW) | (1u << PH_WEXP) | (1u << PH_MOD) | (1u << PH_INPROJ) | (1u << PH_MIX1) | (1u << PH_MIX2) | (1u << PH_MIX3) | (1u << PH_OUTPROJ) | (1u << PH_ROUTE) | (1u << PH_GU) | (1u << PH_DOWN) | (1u << PH_FINAL);
#ifndef MK_DUP_MASK
#define MK_DUP_MASK 0u
#endif
    if (MK_PER_PHASE) { for (int p = 0; p < 12; ++p) if (all & (1u << p)) { launch_mega(a, 1u << p, stream); if (MK_DUP_MASK & (1u << p)) { if (p == PH_ROUTE) (void)hipMemsetAsync(ws + WS_CTL, 0, 4096, stream); launch_mega(a, 1u << p, stream); } } }
    else launch_mega(a, all, stream);
}
```

```cpp
#include <hip/hip_runtime.h>
#include <cstdio>
#include <cstdint>

typedef unsigned short bf16;
typedef float f32x4 __attribute__((ext_vector_type(4)));

constexpr int D = 1024, BATCH = 4, SEQ = 4096, CTXL = 256, GW = 64;
constexpr int T = BATCH * SEQ;
constexpr int TC = BATCH * CTXL;
constexpr int MR = T + TC;
constexpr int DLRU = 512, NBLK = 8, BW = 64;
constexpr int HEADS = 4, DK = 64, DV = 128, DGK = 256, DGV = 512, RANK = 16;
constexpr int DIN = 2576, PP = 2560;
constexpr int NE = 32, TOPK = 4;
constexpr int NMOD = 6;
constexpr float ALPHA = 1.189207115002721f;
constexpr float LN_EPS = 1e-5f, RMS_EPS = 1e-6f;
constexpr int MAXTILES = 544;

constexpr size_t MiB = 1u << 20;
constexpr size_t al(size_t x) { return (x + 255) & ~(size_t)255; }
constexpr size_t WS_CTL = 0, CTL_ZERO_BYTES = 65536;
constexpr size_t WS_MOD = 1 * MiB;
constexpr size_t WS_ROUTE_E = WS_MOD + al(5 * 6144 * 4);
constexpr size_t WS_ROUTE_W = WS_ROUTE_E + al((size_t)T * 4 * 4);
constexpr size_t WS_LIST = WS_ROUTE_W + al((size_t)T * 4 * 4);
constexpr size_t WS_ALOW = WS_LIST + al((size_t)NE * T * 4);
constexpr size_t WS_WTL = WS_ALOW + al((size_t)MR * RANK * 4);
constexpr size_t WS_WR = WS_WTL + al((size_t)2 * 2 * 8 * 64 * 64 * 2);
constexpr size_t WS_SMALL_END = WS_WR + al((size_t)2 * 32 * 1032 * 2);
static_assert(WS_SMALL_END <= 8 * MiB, "small region");
constexpr int NIN = 2816;
constexpr size_t WS_WTIN = 8 * MiB;
constexpr size_t WS_WTOUT = WS_WTIN + (size_t)NIN * D * 2;
constexpr size_t WS_WGU = WS_WTOUT + (size_t)D * D * 2;
constexpr size_t WS_WDN = WS_WGU + (size_t)NE * 2048 * D;
constexpr size_t WS_E = WS_WDN + (size_t)NE * D * D;
constexpr size_t WS_U = WS_E;
constexpr size_t WS_P = WS_U + (size_t)MR * D * 2;
constexpr size_t WS_AGG = WS_P + (size_t)MR * PP * 2;
constexpr size_t WS_CARRY = WS_AGG + al((size_t)272 * 2 * 2 * 512 * 4);
constexpr size_t WS_DEC = WS_CARRY + al((size_t)256 * 2 * 512 * 4);
constexpr size_t WS_MIX_END = WS_DEC + al((size_t)1088 * 2 * 64 * 4);
constexpr size_t WS_ACT = WS_E;
constexpr size_t WS_E_END = WS_MIX_END;
static_assert(WS_ACT + (size_t)MAXTILES * 128 * D <= WS_E_END, "region E");
constexpr size_t WS_F = WS_E_END;
constexpr size_t WS_Y = WS_F;
constexpr size_t WS_H = WS_F;
constexpr size_t WS_KV = WS_F + (size_t)T * D * 2;
constexpr size_t WS_YBUF = WS_F;
constexpr size_t WS_Z = WS_F + (size_t)T * 4 * D;
constexpr size_t WS_END = WS_F + (size_t)T * 4 * D * 2;
static_assert(WS_Z >= WS_F + (size_t)T * D * 2 && WS_Z + (size_t)T * D * 2 <= WS_END, "z in region F");
static_assert(WS_KV + (size_t)1088 * 2 * 128 * 64 * 4 <= WS_END, "kv in region F");
static_assert(WS_END <= 512 * MiB, "workspace map exceeds 512 MiB");

__device__ __forceinline__ float bf2f(bf16 v) { return __uint_as_float(((unsigned)v) << 16); }
typedef float f32x2_cv __attribute__((ext_vector_type(2)));
typedef __bf16 bf16x2_cv __attribute__((ext_vector_type(2)));
__device__ __forceinline__ unsigned pk2(float lo, float hi) { const f32x2_cv v = {lo, hi}; return __builtin_bit_cast(unsigned, __builtin_convertvector(v, bf16x2_cv)); }
__device__ __forceinline__ bf16 f2bf(float f) { return (bf16)(pk2(f, 0.f) & 0xffffu); }
__device__ __forceinline__ float sigmoidf_(float x) { return 1.0f / (1.0f + __expf(-x)); }
__device__ __forceinline__ float siluf_(float x) { return x * sigmoidf_(x); }
__device__ __forceinline__ float gelu_tanh(float x) { const float u = 0.7978845608028654f * (x + 0.044715f * x * x * x); return 0.5f * x * (1.0f + tanhf(u)); }
__device__ __forceinline__ float log_sigmoid(float z) { return -(fmaxf(-z, 0.f) + log1pf(__expf(-fabsf(z)))); }
template <int CTRL> __device__ __forceinline__ float dppf(float v) { return __builtin_bit_cast(float, __builtin_amdgcn_update_dpp(0, __builtin_bit_cast(int, v), CTRL, 0xF, 0xF, true)); }
constexpr int DPP_XOR1 = 0xB1  , DPP_XOR2 = 0x4E  , DPP_XOR7 = 0x141  , DPP_XOR15 = 0x140  ;
__device__ __forceinline__ float rdlane(float v, int l) { return __builtin_bit_cast(float, __builtin_amdgcn_readlane(__builtin_bit_cast(int, v), l)); }
__device__ __forceinline__ float wave_sum(float v) {
    v += dppf<DPP_XOR1>(v); v += dppf<DPP_XOR2>(v); v += dppf<DPP_XOR7>(v); v += dppf<DPP_XOR15>(v);
    return (rdlane(v, 0) + rdlane(v, 16)) + (rdlane(v, 32) + rdlane(v, 48));
}
__device__ __forceinline__ float wave_max(float v) {
    v = fmaxf(v, dppf<DPP_XOR1>(v)); v = fmaxf(v, dppf<DPP_XOR2>(v)); v = fmaxf(v, dppf<DPP_XOR7>(v)); v = fmaxf(v, dppf<DPP_XOR15>(v));
    return fmaxf(fmaxf(rdlane(v, 0), rdlane(v, 16)), fmaxf(rdlane(v, 32), rdlane(v, 48)));
}

struct In {
    const float *x, *c, *ctx, *c_ctx, *w_ada, *b_ada, *w_in, *conv_w, *conv_b, *lru_wa, *lru_ba, *lru_wx, *lru_bx, *lru_lam,
        *gla_wa, *gla_ba, *gla_norm_g, *w_out, *ln1_g, *ln1_b, *w_router, *b_router, *w_gate, *b_gate, *w_up, *b_up, *w_down, *b_down, *ln2_g, *ln2_b;
};

#define LAS __attribute__((address_space(3)))
#define GAS __attribute__((address_space(1)))
typedef short bf16x8 __attribute__((ext_vector_type(8)));
typedef unsigned u32x4 __attribute__((ext_vector_type(4)));
typedef unsigned u32x2 __attribute__((ext_vector_type(2)));
typedef float f32x2 __attribute__((ext_vector_type(2)));

constexpr int NWAVES = 8, NTHR = 512;
constexpr int RING_BYTES = 131072, SCR_BYTES = 147456  , LDSCTL_OFF = SCR_BYTES, LDSTBL_OFF = SCR_BYTES + 512  , LDSTOK_OFF = SCR_BYTES + 1536, LDS_BYTES = 163840;
constexpr int MAXU_GU = 28, MAXU_DN = 14;
static_assert(LDSTOK_OFF + MAXU_GU * 512 <= LDS_BYTES && LDSTOK_OFF + MAXU_DN * 1024 <= LDS_BYTES && LDSTBL_OFF + 320 + 4 * MAXU_GU * 4 + 16 <= LDSTOK_OFF, "LDS tables");

__device__ __forceinline__ unsigned cvt_pk_bf16(float lo, float hi) { return pk2(lo, hi); }
#define LDS_WAIT() asm volatile("s_waitcnt lgkmcnt(0)" ::: "memory")
#define VM_WAIT() asm volatile("s_waitcnt vmcnt(0)" ::: "memory")

namespace pg8 {
constexpr int BM = 256, BK = 64, HALF = 128, HTB = HALF * BK * 2  , STAGE_BYTES = 8 * HTB, NXCD = 8, WGM = 8;
__host__ __device__ __forceinline__ int lds_byte(int r, int c) { const int st = (r >> 4) * 2 + (c >> 5), rr = r & 15, cc = c & 31, ob = rr * 64 + cc * 2; return st * 1024 + (ob ^ (((ob >> 9) & 1) << 5)); }
__host__ __device__ __forceinline__ void stage_rc(int b, int& R, int& C) { const int st = b / 1024, sb = b % 1024, swz = sb ^ (((sb >> 9) & 1) << 5); R = (st >> 1) * 16 + swz / 64; C = (st & 1) * 32 + (swz % 64) / 2; }
__host__ __device__ __forceinline__ int perm32(int rho) { const int n = rho >> 4, i = rho & 15; return 8 * (i >> 2) + 4 * n + (i & 3); }

struct Unit { int pm, pn, e, ord; };
struct Gemm { const void* A; const void* Bt; int Kb; };

struct StaticOrder {
    int nM, nN, nwg, G, c, Kb;
    __device__ void init(int M, int N, int Kb_, int G_, int c_) { nM = M / BM; nN = N / BM; nwg = nM * nN; G = G_; c = c_; Kb = Kb_; }
    __device__ bool next(int i, Unit& u) const {
        const long L = (long)i * G + c; if (L >= nwg) return false;
        int wgid = (int)L; { const int q = nwg / NXCD, r = nwg % NXCD, xcd = wgid % NXCD, off = wgid / NXCD; wgid = (xcd < r ? xcd * (q + 1) : r * (q + 1) + (xcd - r) * q) + off; }
        const int nig = WGM * nN, gid = wgid / nig, fm = gid * WGM, gsz = (nM - fm) < WGM ? (nM - fm) : WGM;
        u.pm = fm + ((wgid % nig) % gsz); u.pn = (wgid % nig) / gsz; u.e = 0; u.ord = i; return true;
    }
    __device__ __forceinline__ unsigned a_off(const Unit& u, int h, int R) const { return (unsigned)(u.pm * BM + h * HALF + R) * (unsigned)Kb; }
};
struct MoeOrder {
    const LAS int* tb; const LAS unsigned* tok; int NT, G, c, U, Kb, gather;
    __device__ bool next(int i, Unit& u) const {
        const int L = i * G + c; if (L >= U) return false;
        int w; { const int q = U / NXCD, r = U % NXCD, xcd = L % NXCD, off = L / NXCD; w = (xcd < r ? xcd * (q + 1) : r * (q + 1) + (xcd - r) * q) + off; }
        int e = 0; while (e < NE - 1 && w >= __builtin_amdgcn_readfirstlane(tb[e + 1]) * NT) ++e;
        const int tbe = __builtin_amdgcn_readfirstlane(tb[e]), tiles = __builtin_amdgcn_readfirstlane(tb[e + 1]) - tbe, idx = w - tbe * NT;
        int mt, pn;
        if (NT == 8) { const int hi = idx / (tiles * 4), rem = idx - hi * tiles * 4; mt = rem >> 2; pn = hi * 4 + (rem & 3); } else { mt = idx >> 2; pn = idx & 3; }
        u.pm = tbe + mt; u.pn = e * NT + pn; u.e = e; u.ord = i; return true;
    }
    __device__ __forceinline__ unsigned a_off(const Unit& u, int h, int R) const { return gather ? tok[u.ord * 256 + h * HALF + R] : (unsigned)(u.pm * BM + h * HALF + R) * (unsigned)Kb; }
};

struct EpiInProj {
    static constexpr bool PERM = true;
    bf16* P; float* alow;
    static __device__ __forceinline__ int prow(int m, bool cm) { return (cm && m < T) ? ((m & ~(SEQ - 1)) | ((m & (GW - 1)) << 6) | ((m >> 6) & (GW - 1))) : m; }
    __device__ __forceinline__ void operator()(const f32x4 (&acc)[2][2][4][2], const Unit& u, int wr, int wc, int fr, int fq) const {
        const int row0 = u.pm * BM + wr * 64 + fr; const bool cm = u.pn >= 4;
        if (u.pn < 10) {
            const int col0 = u.pn * BM + wc * 32 + 8 * fq;
#pragma unroll
            for (int ai = 0; ai < 2; ++ai)
#pragma unroll
                for (int m = 0; m < 4; ++m) { bf16* rowp = P + (size_t)prow(row0 + ai * HALF + m * 16, cm) * PP + col0;
#pragma unroll
                    for (int bj = 0; bj < 2; ++bj) { const f32x4 v0 = acc[ai][bj][m][0], v1 = acc[ai][bj][m][1];
                        u32x4 w; w.x = cvt_pk_bf16(v0[0], v0[1]); w.y = cvt_pk_bf16(v0[2], v0[3]); w.z = cvt_pk_bf16(v1[0], v1[1]); w.w = cvt_pk_bf16(v1[2], v1[3]);
                        *(u32x4*)(rowp + bj * HALF) = w; } }
        } else if (wc == 0 && fq < 2) {
#pragma unroll
            for (int ai = 0; ai < 2; ++ai)
#pragma unroll
                for (int m = 0; m < 4; ++m) { float* rowp = alow + (size_t)prow(row0 + ai * HALF + m * 16, true) * RANK + 8 * fq;
                    *(f32x4*)(rowp) = acc[ai][0][m][0]; *(f32x4*)(rowp + 4) = acc[ai][0][m][1]; }
        }
    }
};
constexpr int ZP = D;
struct EpiOutProj {
    static constexpr bool PERM = true;
    const float* x; const float* mod; bf16* z;
    __device__ __forceinline__ void operator()(const f32x4 (&acc)[2][2][4][2], const Unit& u, int wr, int wc, int fr, int fq) const {
        const int row0 = u.pm * BM + wr * 64 + fr, col0 = u.pn * BM + wc * 32 + 8 * fq;
        const float* g1 = mod + (u.pm / 16) * 6144 + 2048;
        f32x4 gv[2][2];
#pragma unroll
        for (int bj = 0; bj < 2; ++bj)
#pragma unroll
            for (int n = 0; n < 2; ++n) gv[bj][n] = *(const f32x4*)(g1 + col0 + bj * HALF + n * 4);
#pragma unroll
        for (int ai = 0; ai < 2; ++ai)
#pragma unroll
            for (int m = 0; m < 4; ++m) { const size_t off = (size_t)(row0 + ai * HALF + m * 16) * D + col0;
#pragma unroll
                for (int bj = 0; bj < 2; ++bj) { const f32x4 x0 = *(const f32x4*)(x + off + bj * HALF), x1 = *(const f32x4*)(x + off + bj * HALF + 4);
                    const f32x4 v0 = x0 * ALPHA + gv[bj][0] * acc[ai][bj][m][0], v1 = x1 * ALPHA + gv[bj][1] * acc[ai][bj][m][1];
                    u32x4 w; w.x = cvt_pk_bf16(v0[0], v0[1]); w.y = cvt_pk_bf16(v0[2], v0[3]); w.z = cvt_pk_bf16(v1[0], v1[1]); w.w = cvt_pk_bf16(v1[2], v1[3]);
                    *(u32x4*)(z + (size_t)(row0 + ai * HALF + m * 16) * ZP + col0 + bj * HALF) = w; } }
    }
};
struct EpiGU {
    static constexpr bool PERM = true;
    const float* b_gate; const float* b_up; unsigned char* act;
    __device__ __forceinline__ void operator()(const f32x4 (&acc)[2][2][4][2], const Unit& u, int wr, int wc, int fr, int fq) const {
        const int row0 = u.pm * BM + wr * 64 + fr, col0 = (u.pn & 7) * 128 + wc * 32 + 8 * fq;
        f32x4 bg[2], bu[2];
#pragma unroll
        for (int n = 0; n < 2; ++n) { bg[n] = *(const f32x4*)(b_gate + u.e * D + col0 + 4 * n); bu[n] = *(const f32x4*)(b_up + u.e * D + col0 + 4 * n); }
#pragma unroll
        for (int ai = 0; ai < 2; ++ai)
#pragma unroll
            for (int m = 0; m < 4; ++m) { unsigned char* rowp = act + (size_t)(row0 + ai * HALF + m * 16) * D + col0;
                float o[8];
#pragma unroll
                for (int n = 0; n < 2; ++n)
#pragma unroll
                    for (int j = 0; j < 4; ++j) { const float g = fminf(acc[ai][0][m][n][j] + bg[n][j], 7.0f); const float up = fminf(fmaxf(acc[ai][1][m][n][j] + bu[n][j], -7.0f), 7.0f);
                        o[n * 4 + j] = (up + 1.0f) * g * __builtin_amdgcn_rcpf(1.0f + __expf(-1.702f * g)); }
                u32x2 w; w.x = 0u; w.y = 0u;
                w.x = __builtin_amdgcn_cvt_pk_fp8_f32(o[0], o[1], w.x, false); w.x = __builtin_amdgcn_cvt_pk_fp8_f32(o[2], o[3], w.x, true);
                w.y = __builtin_amdgcn_cvt_pk_fp8_f32(o[4], o[5], w.y, false); w.y = __builtin_amdgcn_cvt_pk_fp8_f32(o[6], o[7], w.y, true);
                *(u32x2*)rowp = w; }
    }
};
struct EpiDown {
    static constexpr bool PERM = true;
    const float* b_down; bf16* ybuf; const LAS int* dtab; const LAS float* wtab;
    __device__ __forceinline__ void operator()(const f32x4 (&acc)[2][2][4][2], const Unit& u, int wr, int wc, int fr, int fq) const {
        const int rl0 = wr * 64 + fr, col0 = (u.pn & 3) * BM + wc * 32 + 8 * fq;
        f32x4 bv[2][2];
#pragma unroll
        for (int bj = 0; bj < 2; ++bj)
#pragma unroll
            for (int n = 0; n < 2; ++n) bv[bj][n] = *(const f32x4*)(b_down + u.e * D + col0 + bj * HALF + 4 * n);
#pragma unroll
        for (int ai = 0; ai < 2; ++ai)
#pragma unroll
            for (int m = 0; m < 4; ++m) { const int rl = rl0 + ai * HALF + m * 16; const int dest = dtab[u.ord * 256 + rl]; const float wg = wtab[u.ord * 256 + rl];
                if (dest >= 0) { bf16* rowp = ybuf + (size_t)dest * D + col0;
#pragma unroll
                    for (int bj = 0; bj < 2; ++bj) { const f32x4 v0 = (acc[ai][bj][m][0] + bv[bj][0]) * wg, v1 = (acc[ai][bj][m][1] + bv[bj][1]) * wg;
                        u32x4 w; w.x = cvt_pk_bf16(v0[0], v0[1]); w.y = cvt_pk_bf16(v0[2], v0[3]); w.z = cvt_pk_bf16(v1[0], v1[1]); w.w = cvt_pk_bf16(v1[2], v1[3]);
                        *(u32x4*)(rowp + bj * HALF) = w; } } }
    }
};

typedef int v8i __attribute__((ext_vector_type(8)));
typedef int v4i __attribute__((ext_vector_type(4)));
__device__ __forceinline__ const char* uptr(const char* p) { const unsigned long long v = (unsigned long long)p; const unsigned lo = __builtin_amdgcn_readfirstlane((unsigned)v), hi = __builtin_amdgcn_readfirstlane((unsigned)(v >> 32)); return (const char*)(((unsigned long long)hi << 32) | lo); }
template <class Epi, class Sched, bool ALIGN_EPI, bool F8>
__device__ __forceinline__ void gemm_phase(LAS unsigned char* lds, const Gemm g, const Sched& S, const Epi& E) {
    const int tid = threadIdx.x, wid = __builtin_amdgcn_readfirstlane(tid >> 6), lane = tid & 63, wr = wid >> 2, wc = wid & 3, fr = lane & 15, fq = lane >> 4;
    const int Kb = g.Kb, nt = Kb / 128;
    unsigned voffB[2];
#pragma unroll
    for (int i = 0; i < 2; ++i) { int R, C; stage_rc(tid * 16 + i * 8192, R, C); const int Rb = Epi::PERM ? ((R & ~31) + perm32(R & 31)) : R;
        voffB[i] = (unsigned)(Rb * Kb + C * 2); }
    const size_t kstep = (size_t)128;
    const size_t hstep = (size_t)HALF * Kb;
    const size_t tstep = 2 * hstep;
    const unsigned ldsw = (unsigned)wid * 1024u;
    const int aoff = F8 ? lds_byte(wr * 64 + fr, fq * 16) : lds_byte(wr * 64 + fr, fq * 8), boff = F8 ? lds_byte(wc * 32 + fr, fq * 16) : lds_byte(wc * 32 + fr, fq * 8);
#define PG8_SA(b, h) (((b) * 2 + (h)) * HTB)
#define PG8_SB(b, h) ((4 + (b) * 2 + (h)) * HTB)
#define PG8_STAGE2(bufoff, gbase, h_) do { _Pragma("unroll") for (int _i = 0; _i < 2; ++_i) \
        __builtin_amdgcn_global_load_lds((const unsigned*)(uptr((const char*)(gbase)) + (last ? nvo[h_][_i] : vo[h_][_i])), (LAS unsigned*)(lds + (bufoff) + ldsw + _i * 8192), 16, 0, 0); } while (0)
#define PG8_STAGE(bufoff, gbase, voff) do { _Pragma("unroll") for (int _i = 0; _i < 2; ++_i) { unsigned _o = (voff)[_i]; asm volatile("" : "+v"(_o));     \
        __builtin_amdgcn_global_load_lds((const unsigned*)(uptr((const char*)(gbase)) + _o), (LAS unsigned*)(lds + (bufoff) + ldsw + _i * 8192), 16, 0, 0); } } while (0)
#define PG8_LDA(dst, b, h) do { if constexpr (F8) { _Pragma("unroll") for (int m = 0; m < 4; ++m) { const LAS v4i* _p = (const LAS v4i*)(lds + PG8_SA(b, h) + aoff + m * 2048); dst##8[m] = __builtin_shufflevector(_p[0], _p[1], 0, 1, 2, 3, 4, 5, 6, 7); } } \
        else { _Pragma("unroll") for (int m = 0; m < 4; ++m) _Pragma("unroll") for (int k = 0; k < 2; ++k) dst[m][k] = *(const LAS bf16x8*)(lds + PG8_SA(b, h) + aoff + m * 2048 + k * 1024); } } while (0)
#define PG8_LDB(dst, b, h) do { if constexpr (F8) { _Pragma("unroll") for (int n = 0; n < 2; ++n) { const LAS v4i* _p = (const LAS v4i*)(lds + PG8_SB(b, h) + boff + n * 2048); dst##8[n] = __builtin_shufflevector(_p[0], _p[1], 0, 1, 2, 3, 4, 5, 6, 7); } } \
        else { _Pragma("unroll") for (int n = 0; n < 2; ++n) _Pragma("unroll") for (int k = 0; k < 2; ++k) dst[n][k] = *(const LAS bf16x8*)(lds + PG8_SB(b, h) + boff + n * 2048 + k * 1024); } } while (0)
#define PG8_MMA(ai, bj, At, Bt) do { __builtin_amdgcn_s_setprio(1); if constexpr (F8) { _Pragma("unroll") for (int m = 0; m < 4; ++m) _Pragma("unroll") for (int n = 0; n < 2; ++n) \
        acc[ai][bj][m][n] = __builtin_amdgcn_mfma_scale_f32_16x16x128_f8f6f4(Bt##8[n], At##8[m], acc[ai][bj][m][n], 0, 0, 0, 0x79797979, 0, 0x7F7F7F7F); } \
        else { _Pragma("unroll") for (int m = 0; m < 4; ++m) _Pragma("unroll") for (int n = 0; n < 2; ++n) _Pragma("unroll") for (int k = 0; k < 2; ++k) \
        acc[ai][bj][m][n] = __builtin_amdgcn_mfma_f32_16x16x32_bf16(Bt[n][k], At[m][k], acc[ai][bj][m][n], 0, 0, 0); } __builtin_amdgcn_s_setprio(0); } while (0)
#define PG8_WAIT_V(n) asm volatile("s_waitcnt vmcnt(" #n ")" ::: "memory")
#define PG8_WAIT_L(n) asm volatile("s_waitcnt lgkmcnt(" #n ")" ::: "memory")
#define PG8_BAR __builtin_amdgcn_s_barrier()
#define PG8_SCHED __builtin_amdgcn_sched_barrier(0)
#define PG8_AOFF(dst, u) do { _Pragma("unroll") for (int _i = 0; _i < 2; ++_i) { int _R, _C; stage_rc((int)threadIdx.x * 16 + _i * 8192, _R, _C); _Pragma("unroll") for (int _h = 0; _h < 2; ++_h) dst[_h][_i] = S.a_off(u, _h, _R) + (unsigned)(_C * 2); } } while (0)
    Unit cur, nxt; int ui = 0;
    if (!S.next(0, cur)) return;
    f32x4 acc[2][2][4][2];
#pragma unroll
    for (int a = 0; a < 2; ++a)
#pragma unroll
        for (int b = 0; b < 2; ++b)
#pragma unroll
            for (int m = 0; m < 4; ++m)
#pragma unroll
                for (int n = 0; n < 2; ++n) acc[a][b][m][n] = (f32x4){0.f, 0.f, 0.f, 0.f};
    bf16x8 At[4][2], B0[2][2], B1[2][2]; v8i At8[4], B08[2], B18[2];
    unsigned vo[2][2], nvo[2][2];
    PG8_AOFF(vo, cur);
    const char* gA = (const char*)g.A; const char* cB = (const char*)g.Bt + (size_t)cur.pn * tstep;
    PG8_STAGE(PG8_SB(0, 0), cB, voffB); PG8_STAGE(PG8_SB(0, 1), cB + hstep, voffB); PG8_STAGE(PG8_SA(0, 0), gA, vo[0]); PG8_STAGE(PG8_SA(0, 1), gA, vo[1]);
    if (wr == 1) PG8_BAR;
    PG8_WAIT_V(2); PG8_BAR;
    PG8_STAGE(PG8_SB(1, 0), cB + kstep, voffB); PG8_STAGE(PG8_SA(1, 0), gA + kstep, vo[0]); PG8_STAGE(PG8_SB(1, 1), cB + hstep + kstep, voffB);
    PG8_WAIT_V(6); PG8_BAR;
    for (;;) {
        const bool has_next = S.next(ui + 1, nxt);
        const char* nB = has_next ? (const char*)g.Bt + (size_t)nxt.pn * tstep : cB;
        if (has_next) { PG8_AOFF(nvo, nxt); } else {
#pragma unroll
            for (int h = 0; h < 2; ++h)
#pragma unroll
                for (int i = 0; i < 2; ++i) nvo[h][i] = vo[h][i]; }
#pragma unroll 1
        for (int t = 0; t < nt; t += 2) {
            const bool last = (t == nt - 2);
            const char* ka1 = gA + (size_t)(t + 1) * kstep;
            const char* ka2 = last ? gA : gA + (size_t)(t + 2) * kstep; const char* b2 = last ? nB : cB + (size_t)(t + 2) * kstep;
            const char* ka3 = ka2 + kstep; const char* b3 = b2 + kstep;
            PG8_LDB(B0, 0, 0); PG8_LDB(B1, 0, 1); PG8_SCHED; PG8_LDA(At, 0, 0); PG8_STAGE(PG8_SA(1, 1), ka1, vo[1]);
            PG8_WAIT_V(8); PG8_WAIT_L(0); PG8_BAR; PG8_SCHED; PG8_MMA(0, 0, At, B0); PG8_MMA(0, 1, At, B1); PG8_SCHED; PG8_BAR; PG8_SCHED;
            PG8_LDA(At, 0, 1); PG8_STAGE(PG8_SB(0, 0), b2, voffB); PG8_STAGE(PG8_SB(0, 1), b2 + hstep, voffB); PG8_STAGE2(PG8_SA(0, 0), ka2, 0);
            PG8_WAIT_V(8); PG8_WAIT_L(0); PG8_BAR; PG8_SCHED; PG8_MMA(1, 0, At, B0); PG8_MMA(1, 1, At, B1); PG8_SCHED; PG8_BAR; PG8_SCHED;
            PG8_LDB(B0, 1, 0); PG8_LDB(B1, 1, 1); PG8_SCHED; PG8_LDA(At, 1, 0); PG8_STAGE2(PG8_SA(0, 1), ka2, 1);
            PG8_WAIT_V(8); PG8_WAIT_L(0); PG8_BAR; PG8_SCHED; PG8_MMA(0, 0, At, B0); PG8_MMA(0, 1, At, B1); PG8_SCHED; PG8_BAR; PG8_SCHED;
            PG8_LDA(At, 1, 1); PG8_STAGE(PG8_SB(1, 0), b3, voffB); PG8_STAGE(PG8_SB(1, 1), b3 + hstep, voffB); PG8_STAGE2(PG8_SA(1, 0), ka3, 0);
            PG8_WAIT_V(8); PG8_WAIT_L(0); PG8_BAR; PG8_SCHED; PG8_MMA(1, 0, At, B0); PG8_MMA(1, 1, At, B1); PG8_SCHED; PG8_BAR; PG8_SCHED;
        }
        if constexpr (ALIGN_EPI) { if (wr == 0) PG8_BAR; }
        E(acc, cur, wr, wc, fr, fq);
        if (!has_next) break;
#pragma unroll
        for (int a = 0; a < 2; ++a)
#pragma unroll
            for (int b = 0; b < 2; ++b)
#pragma unroll
                for (int m = 0; m < 4; ++m)
#pragma unroll
                    for (int n = 0; n < 2; ++n) acc[a][b][m][n] = (f32x4){0.f, 0.f, 0.f, 0.f};
        cur = nxt; cB = nB; ++ui;
#pragma unroll
        for (int h = 0; h < 2; ++h)
#pragma unroll
            for (int i = 0; i < 2; ++i) vo[h][i] = nvo[h][i];
        if constexpr (ALIGN_EPI) { if (wr == 1) PG8_BAR; }
    }
    PG8_WAIT_V(0);
    if constexpr (!ALIGN_EPI) { if (wr == 0) PG8_BAR; }
    PG8_BAR;
#undef PG8_SA
#undef PG8_SB
#undef PG8_STAGE
#undef PG8_STAGE2
#undef PG8_LDA
#undef PG8_LDB
#undef PG8_MMA
#undef PG8_WAIT_V
#undef PG8_WAIT_L
#undef PG8_BAR
#undef PG8_SCHED
#undef PG8_AOFF
}

struct MoeOrder8 {
    const LAS int* ut; const LAS unsigned* tok; int nu, Kb, gather;
    __device__ __forceinline__ bool next(int i, Unit& u) const {
        if (i >= nu) return false;
        u.pm = __builtin_amdgcn_readfirstlane(ut[4 * i]); u.pn = __builtin_amdgcn_readfirstlane(ut[4 * i + 1]); u.e = __builtin_amdgcn_readfirstlane(ut[4 * i + 2]); u.ord = i; return true;
    }
    __device__ __forceinline__ unsigned a_off(const Unit& u, int R) const { return gather ? tok[u.ord * 128 + R] : (unsigned)(u.pm * 128 + R) * (unsigned)Kb; }
};
__device__ __forceinline__ void moe_unit_table(const LAS int* tb, LAS int* ut, LAS int* nu_out, int NT, int G, int c, int cap, int tid) {
    const int U = tb[NE] * NT;
    if (tid < cap) {
        const int L = tid * G + c;
        if (L < U) {
            int w; { const int q = U / NXCD, r = U % NXCD, xcd = L % NXCD, off = L / NXCD; w = (xcd < r ? xcd * (q + 1) : r * (q + 1) + (xcd - r) * q) + off; }
            int e = 0; while (e < NE - 1 && w >= tb[e + 1] * NT) ++e;
            const int tbe = tb[e], tiles = tb[e + 1] - tbe, idx = w - tbe * NT;
            int mt, pn;
            if (NT == 8) { mt = idx >> 3; pn = idx & 7; } else { mt = idx >> 2; pn = idx & 3; }
            ut[4 * tid] = tbe + mt; ut[4 * tid + 1] = e * NT + pn; ut[4 * tid + 2] = e;
        }
    }
    if (tid == 0) { const int n = (U - c + G - 1) / G; *nu_out = n < 0 ? 0 : (n > cap ? cap : n); }
}
struct EpiGU8 {
    const float* b_gate; const float* b_up; unsigned char* act;
    struct Pre { f32x4 bg[2], bu[2]; };
    __device__ __forceinline__ void prefetch(Pre& p, const Unit& u, int wr, int wc, int fr, int fq) const {
        const int col0 = (u.pn & 7) * 128 + wc * 32 + 8 * fq;
#pragma unroll
        for (int n = 0; n < 2; ++n) { p.bg[n] = *(const f32x4*)(b_gate + u.e * D + col0 + 4 * n); p.bu[n] = *(const f32x4*)(b_up + u.e * D + col0 + 4 * n); }
    }
    __device__ __forceinline__ void operator()(const f32x4 (&acc)[2][4][2], const Pre& p, const Unit& u, int wr, int wc, int fr, int fq) const {
        const int row0 = u.pm * 128 + wr * 64 + fr, col0 = (u.pn & 7) * 128 + wc * 32 + 8 * fq;
#pragma unroll
        for (int m = 0; m < 4; ++m) { unsigned char* rowp = act + (size_t)(row0 + m * 16) * D + col0;
            float o[8];
#pragma unroll
            for (int n = 0; n < 2; ++n)
#pragma unroll
                for (int j = 0; j < 4; ++j) { const float gt = fminf(acc[0][m][n][j] + p.bg[n][j], 7.0f); const float up = fminf(fmaxf(acc[1][m][n][j] + p.bu[n][j], -7.0f), 7.0f);
                    o[n * 4 + j] = (up + 1.0f) * gt * __builtin_amdgcn_rcpf(1.0f + __builtin_amdgcn_exp2f(-2.4554669595930156f * gt)); }
            u32x2 w; w.x = 0u; w.y = 0u;
            w.x = __builtin_amdgcn_cvt_pk_fp8_f32(o[0], o[1], w.x, false); w.x = __builtin_amdgcn_cvt_pk_fp8_f32(o[2], o[3], w.x, true);
            w.y = __builtin_amdgcn_cvt_pk_fp8_f32(o[4], o[5], w.y, false); w.y = __builtin_amdgcn_cvt_pk_fp8_f32(o[6], o[7], w.y, true);
            *(u32x2*)rowp = w; }
    }
};
constexpr float YSCALE = 32.0f;
struct EpiDown8 {
    const float* b_down; unsigned char* ybuf; const LAS int* dtab; const LAS float* wtab;
    struct Pre { f32x4 bv[2][2]; };
    __device__ __forceinline__ void prefetch(Pre& p, const Unit& u, int wr, int wc, int fr, int fq) const {
        const int col0 = (u.pn & 3) * 256 + wc * 32 + 8 * fq;
#pragma unroll
        for (int bj = 0; bj < 2; ++bj)
#pragma unroll
            for (int n = 0; n < 2; ++n) p.bv[bj][n] = *(const f32x4*)(b_down + u.e * D + col0 + bj * 128 + 4 * n);
    }
    __device__ __forceinline__ void operator()(const f32x4 (&acc)[2][4][2], const Pre& p, const Unit& u, int wr, int wc, int fr, int fq) const {
        const int rl0 = wr * 64 + fr, col0 = (u.pn & 3) * 256 + wc * 32 + 8 * fq;
#pragma unroll
        for (int m = 0; m < 4; ++m) { const int rl = rl0 + m * 16; const int dest = dtab[u.ord * 128 + rl]; const float wg = wtab[u.ord * 128 + rl] * YSCALE;
            if (dest >= 0) { unsigned char* rowp = ybuf + (size_t)dest * D + col0;
#pragma unroll
                for (int bj = 0; bj < 2; ++bj) { f32x4 v0 = (acc[bj][m][0] + p.bv[bj][0]) * wg, v1 = (acc[bj][m][1] + p.bv[bj][1]) * wg;
#pragma unroll
                    for (int q = 0; q < 4; ++q) { v0[q] = __builtin_amdgcn_fmed3f(v0[q], -448.0f, 448.0f); v1[q] = __builtin_amdgcn_fmed3f(v1[q], -448.0f, 448.0f); }
                    u32x2 w; w.x = 0u; w.y = 0u;
                    w.x = __builtin_amdgcn_cvt_pk_fp8_f32(v0[0], v0[1], w.x, false); w.x = __builtin_amdgcn_cvt_pk_fp8_f32(v0[2], v0[3], w.x, true);
                    w.y = __builtin_amdgcn_cvt_pk_fp8_f32(v1[0], v1[1], w.y, false); w.y = __builtin_amdgcn_cvt_pk_fp8_f32(v1[2], v1[3], w.y, true);
                    *(u32x2*)(rowp + bj * 128) = w; } } }
    }
};
template <class Epi>
__device__ __forceinline__ void gemm_phase8(LAS unsigned char* lds, const Gemm g, const MoeOrder8& S, const Epi& E) {
    const int tid = threadIdx.x, wid = __builtin_amdgcn_readfirstlane(tid >> 6), lane = tid & 63, wr = wid >> 2, wc = wid & 3, fr = lane & 15, fq = lane >> 4;
    const int Kb = g.Kb, nt = Kb / 128;
    unsigned voffB[2];
#pragma unroll
    for (int i = 0; i < 2; ++i) { int R, C; stage_rc(tid * 16 + i * 8192, R, C); const int Rb = (R & ~31) + perm32(R & 31); voffB[i] = (unsigned)(Rb * Kb + C * 2); }
    const size_t hstep = (size_t)HALF * Kb, tstep = 2 * hstep;
    const unsigned ldsw = (unsigned)wid * 1024u;
    const int aoff = lds_byte(wr * 64 + fr, fq * 16), boff = lds_byte(wc * 32 + fr, fq * 16);
    const int sw1 = (fq & 1) * 16, sw2 = 16 - sw1;
    constexpr unsigned SLOT = 3 * HTB;
#define P8_STG(ldsoff, gbase, off_) do { _Pragma("unroll") for (int _i = 0; _i < 2; ++_i) { unsigned _o = (off_)[_i]; asm volatile("" : "+v"(_o)); \
        __builtin_amdgcn_global_load_lds((const unsigned*)(uptr((const char*)(gbase)) + _o), (LAS unsigned*)(lds + (ldsoff) + ldsw + _i * 8192), 16, 0, 0); } } while (0)
#define P8_AOFF(dst, u) do { _Pragma("unroll") for (int _i = 0; _i < 2; ++_i) { int _R, _C; stage_rc((int)threadIdx.x * 16 + _i * 8192, _R, _C); dst[_i] = S.a_off(u, _R) + (unsigned)(_C * 2); } } while (0)
#define P8_WAIT_V(n) asm volatile("s_waitcnt vmcnt(" #n ")" ::: "memory")
#define P8_WAIT_L(n) asm volatile("s_waitcnt lgkmcnt(" #n ")" ::: "memory")
#define P8_BAR __builtin_amdgcn_s_barrier()
#define P8_SCHED __builtin_amdgcn_sched_barrier(0)
    Unit cur, nxt; int ui = 0;
    if (!S.next(0, cur)) return;
    f32x4 acc[2][4][2];
#pragma unroll
    for (int b = 0; b < 2; ++b)
#pragma unroll
        for (int m = 0; m < 4; ++m)
#pragma unroll
            for (int n = 0; n < 2; ++n) acc[b][m][n] = (f32x4){0.f, 0.f, 0.f, 0.f};
    v8i At8[4], B08[2], B18[2];
    unsigned vo[2], nvo[2];
    P8_AOFF(vo, cur);
    const char* gA = (const char*)g.A; const char* cB = (const char*)g.Bt + (size_t)cur.pn * tstep;
    P8_STG(HTB, cB, voffB); P8_STG(2 * HTB, cB + hstep, voffB); P8_STG(0, gA, vo);
    P8_STG(SLOT + HTB, cB + 128, voffB); P8_STG(SLOT + 2 * HTB, cB + hstep + 128, voffB); P8_STG(SLOT, gA + 128, vo);
    P8_WAIT_V(6);
    if (wr == 1) P8_BAR;
    P8_BAR;
    unsigned rs = 0u, ws = 2u * SLOT;
    for (;;) {
        const bool has_next = S.next(ui + 1, nxt);
        const char* nB = has_next ? (const char*)g.Bt + (size_t)nxt.pn * tstep : cB;
        if (has_next) { P8_AOFF(nvo, nxt); } else { nvo[0] = vo[0]; nvo[1] = vo[1]; }
        typename Epi::Pre pre; E.prefetch(pre, cur, wr, wc, fr, fq);
#pragma unroll 1
        for (int t = 0; t < nt; ++t) {
            const bool wrap = (t + 2 >= nt); const int kt = wrap ? t + 2 - nt : t + 2;
            const char* kb = (wrap ? nB : cB) + (size_t)kt * 128; const char* ka = gA + (size_t)kt * 128;
            unsigned ao[2]; ao[0] = wrap ? nvo[0] : vo[0]; ao[1] = wrap ? nvo[1] : vo[1];
#pragma unroll
            for (int n = 0; n < 2; ++n) { const LAS unsigned char* q0 = lds + rs + HTB + boff + n * 2048; const LAS unsigned char* q1 = lds + rs + 2 * HTB + boff + n * 2048;
                B08[n] = __builtin_shufflevector(*(const LAS v4i*)(q0 + sw1), *(const LAS v4i*)(q0 + sw2), 0, 1, 2, 3, 4, 5, 6, 7); B18[n] = __builtin_shufflevector(*(const LAS v4i*)(q1 + sw1), *(const LAS v4i*)(q1 + sw2), 0, 1, 2, 3, 4, 5, 6, 7); }
            P8_SCHED;
#pragma unroll
            for (int m = 0; m < 4; ++m) { const LAS unsigned char* q = lds + rs + aoff + m * 2048; At8[m] = __builtin_shufflevector(*(const LAS v4i*)(q + sw1), *(const LAS v4i*)(q + sw2), 0, 1, 2, 3, 4, 5, 6, 7); }
            P8_STG(ws + HTB, kb, voffB); P8_STG(ws + 2 * HTB, kb + hstep, voffB); P8_STG(ws, ka, ao);
            P8_WAIT_V(6); P8_WAIT_L(0); P8_BAR; P8_SCHED;
            __builtin_amdgcn_s_setprio(1);
#pragma unroll
            for (int m = 0; m < 4; ++m)
#pragma unroll
                for (int n = 0; n < 2; ++n) { acc[0][m][n] = __builtin_amdgcn_mfma_scale_f32_16x16x128_f8f6f4(B08[n], At8[m], acc[0][m][n], 0, 0, 0, 0x79797979, 0, 0x7F7F7F7F);
                                              acc[1][m][n] = __builtin_amdgcn_mfma_scale_f32_16x16x128_f8f6f4(B18[n], At8[m], acc[1][m][n], 0, 0, 0, 0x79797979, 0, 0x7F7F7F7F); }
            __builtin_amdgcn_s_setprio(0);
            P8_SCHED; P8_BAR; P8_SCHED;
            rs = (rs == 2u * SLOT) ? 0u : rs + SLOT; ws = (ws == 2u * SLOT) ? 0u : ws + SLOT;
        }
        if (wr == 0) P8_BAR;
        E(acc, pre, cur, wr, wc, fr, fq);
        if (!has_next) break;
#pragma unroll
        for (int b = 0; b < 2; ++b)
#pragma unroll
            for (int m = 0; m < 4; ++m)
#pragma unroll
                for (int n = 0; n < 2; ++n) acc[b][m][n] = (f32x4){0.f, 0.f, 0.f, 0.f};
        cur = nxt; cB = nB; ++ui; vo[0] = nvo[0]; vo[1] = nvo[1];
        if (wr == 1) P8_BAR;
    }
    P8_WAIT_V(0);
    P8_BAR;
#undef P8_STG
#undef P8_AOFF
#undef P8_WAIT_V
#undef P8_WAIT_L
#undef P8_BAR
#undef P8_SCHED
}
}

enum Phase { PH_SMALLW = 0, PH_WEXP = 1, PH_MOD = 2, PH_INPROJ = 3, PH_MIX1 = 4, PH_MIX2 = 5, PH_MIX3 = 6, PH_OUTPROJ = 7, PH_ROUTE = 8, PH_GU = 9, PH_DOWN = 10, PH_FINAL = 11 };
struct Args { In in; float* out; unsigned char* ws; unsigned phases; unsigned pad; };

__device__ __forceinline__ void tr_item(const float* W, int ldw, int k0, int n0, int nvalid, bf16* dst, int ldk, LAS float* scr, int lane) {
    { const int nn = lane & 31, nc = nn < nvalid ? nn : 0; const float* wp = W + (size_t)(k0 + (lane >> 5)) * ldw + n0 + nc; float rg[32];
#pragma unroll
      for (int i = 0; i < 32; ++i) rg[i] = wp[(size_t)(2 * i) * ldw];
#pragma unroll
      for (int i = 0; i < 32; ++i) scr[(2 * i + (lane >> 5)) * 33 + nn] = nn < nvalid ? rg[i] : 0.f; }
    LDS_WAIT(); asm volatile("" ::: "memory");
    const int c = lane & 7;
#pragma unroll
    for (int j = 0; j < 4; ++j) { const int n = (lane >> 3) + 8 * j; const LAS float* sp = scr + (8 * c) * 33 + n;
        u32x4 o; o.x = pk2(sp[0 * 33], sp[1 * 33]); o.y = pk2(sp[2 * 33], sp[3 * 33]); o.z = pk2(sp[4 * 33], sp[5 * 33]); o.w = pk2(sp[6 * 33], sp[7 * 33]);
        if (n < nvalid) *(u32x4*)(dst + (size_t)n * ldk + k0 + 8 * c) = o; }
    LDS_WAIT(); asm volatile("" ::: "memory");
}


__device__ __forceinline__ void tr_item8(const float* W, int ldw, int k0, int n0, unsigned char* dst, int ldk, LAS float* scr, int lane) {
    f32x4 raw[8];
#pragma unroll
    for (int i = 0; i < 8; ++i) raw[i] = __builtin_nontemporal_load((const f32x4*)(W + (size_t)(k0 + i * 8 + (lane >> 3)) * ldw + n0 + (lane & 7) * 4));
#pragma unroll
    for (int i = 0; i < 8; ++i) { LAS float* sp = scr + (i * 8 + (lane >> 3)) * 33 + (lane & 7) * 4;
#pragma unroll
        for (int j = 0; j < 4; ++j) sp[j] = raw[i][j] * 64.0f; }
    LDS_WAIT(); asm volatile("" ::: "memory");
    const int c = lane & 7;
#pragma unroll
    for (int j = 0; j < 4; ++j) { const int n = (lane >> 3) + 8 * j; const LAS float* sp = scr + (8 * c) * 33 + n;
        u32x2 o; o.x = 0u; o.y = 0u;
        o.x = __builtin_amdgcn_cvt_pk_fp8_f32(sp[0 * 33], sp[1 * 33], o.x, false); o.x = __builtin_amdgcn_cvt_pk_fp8_f32(sp[2 * 33], sp[3 * 33], o.x, true);
        o.y = __builtin_amdgcn_cvt_pk_fp8_f32(sp[4 * 33], sp[5 * 33], o.y, false); o.y = __builtin_amdgcn_cvt_pk_fp8_f32(sp[6 * 33], sp[7 * 33], o.y, true);
        *(u32x2*)(dst + (size_t)n * ldk + k0 + 8 * c) = o; }
    LDS_WAIT(); asm volatile("" ::: "memory");
}

__device__ __forceinline__ float fast_sigmoid(float x) { return __builtin_amdgcn_rcpf(1.0f + __expf(-x)); }
__device__ __forceinline__ float gelu_tanh_fast(float x) { const float u = 1.5957691216057308f * (x + 0.044715f * x * x * x); return x * fast_sigmoid(u); }
__device__ __forceinline__ bf16x8 pack8(const float (&v)[8]) { u32x4 w; w.x = pk2(v[0], v[1]); w.y = pk2(v[2], v[3]); w.z = pk2(v[4], v[5]); w.w = pk2(v[6], v[7]); return __builtin_bit_cast(bf16x8, w); }
__device__ __forceinline__ void unpack8(const u32x4 w, float (&v)[8]) {
    v[0] = __uint_as_float(w.x << 16); v[1] = __uint_as_float(w.x & 0xffff0000u); v[2] = __uint_as_float(w.y << 16); v[3] = __uint_as_float(w.y & 0xffff0000u);
    v[4] = __uint_as_float(w.z << 16); v[5] = __uint_as_float(w.z & 0xffff0000u); v[6] = __uint_as_float(w.w << 16); v[7] = __uint_as_float(w.w & 0xffff0000u); }

constexpr int LRU_WAVE_LDS = 9216 + 8192;
template <bool FINAL, int DIR>
__device__ __forceinline__ void lru_dir(const In& in, const bf16* P, const bf16* WtL, int line, int cb, int m0, LAS unsigned char* xsl, LAS f32x2* abl, int lane, float* agg, const float* carry, bf16* Y) {
    constexpr int d = DIR;
    const int fr = lane & 15, fq = lane >> 4;
    bf16x8 bfr[2][4][2];
#pragma unroll
    for (int g = 0; g < 2; ++g)
#pragma unroll
        for (int nt = 0; nt < 4; ++nt)
#pragma unroll
            for (int ks = 0; ks < 2; ++ks) bfr[g][nt][ks] = *(const bf16x8*)(WtL + ((size_t)(((d * 2 + g) * 8 + cb) * 64 + nt * 16 + fr)) * 64 + ks * 32 + fq * 8);
    float ba[4], bx[4], cl[4];
#pragma unroll
    for (int nt = 0; nt < 4; ++nt) { const int ch = d * DLRU + cb * 64 + nt * 16 + fr; ba[nt] = -1.4426950408889634f * in.lru_ba[ch]; bx[nt] = -1.4426950408889634f * in.lru_bx[ch]; cl[nt] = -8.0f * 1.4426950408889634f * __logf(1.0f + __expf(-in.lru_lam[ch])); }
    float h = 0.f, aprod = 1.f;
    if (FINAL) h = carry[((size_t)line * 2 + d) * DLRU + cb * 64 + lane];
#pragma unroll 1
    for (int mi = 0; mi < 4; ++mi) {
        const int mt = d == 0 ? mi : 3 - mi;
        unsigned short gt[16], hq[16];
        if (FINAL && d == 1) {
#pragma unroll
            for (int t = 0; t < 16; ++t) { gt[t] = P[(size_t)(m0 + mt * 16 + t) * PP + 512 + cb * 64 + lane]; hq[t] = Y[(size_t)(m0 + mt * 16 + t) * D + cb * 64 + lane]; } }
        bf16x8 af[2];
#pragma unroll
        for (int ks = 0; ks < 2; ++ks) af[ks] = *(const LAS bf16x8*)(xsl + (mt * 16 + fr) * 144 + ks * 64 + fq * 16);
        f32x4 acc[2][4];
#pragma unroll
        for (int g = 0; g < 2; ++g)
#pragma unroll
            for (int nt = 0; nt < 4; ++nt) { const float bz = g == 0 ? ba[nt] : bx[nt]; acc[g][nt] = (f32x4){bz, bz, bz, bz};
#pragma unroll
                for (int ks = 0; ks < 2; ++ks) acc[g][nt] = __builtin_amdgcn_mfma_f32_16x16x32_bf16(af[ks], bfr[g][nt][ks], acc[g][nt], 0, 0, 0); }
#pragma unroll
        for (int nt = 0; nt < 4; ++nt)
#pragma unroll
            for (int j = 0; j < 4; ++j) { const int tokl = 4 * fq + j, chl = nt * 16 + fr;
                const float rg = __builtin_amdgcn_rcpf(1.0f + __builtin_amdgcn_exp2f(acc[0][nt][j])), ig = __builtin_amdgcn_rcpf(1.0f + __builtin_amdgcn_exp2f(acc[1][nt][j]));
                const float a = __builtin_amdgcn_exp2f(cl[nt] * rg);
                const float xv = __uint_as_float(((unsigned)*(const LAS unsigned short*)(xsl + (mt * 16 + tokl) * 144 + chl * 2)) << 16);
                const float bb = __builtin_amdgcn_sqrtf(fmaxf(1.0f - a * a, 0.f)) * (ig * xv);
                abl[tokl * 64 + chl] = (f32x2){a, bb}; }
        LDS_WAIT();
#pragma unroll
        for (int half = 0; half < 2; ++half) {
            const int hb = d == 0 ? half : 1 - half;
            f32x2 abv[8];
#pragma unroll
            for (int t = 0; t < 8; ++t) abv[t] = abl[(hb * 8 + t) * 64 + lane];
#pragma unroll
            for (int sidx = 0; sidx < 8; ++sidx) {
                const int t8 = d == 0 ? sidx : 7 - sidx, tokl = hb * 8 + t8, idx = mt * 16 + tokl;
                h = abv[t8].x * h + abv[t8].y; asm volatile("" : "+v"(h));
                if (!FINAL) aprod *= abv[t8].x;
                if (FINAL) {
                    bf16* yp = Y + (size_t)(m0 + idx) * D + cb * 64 + lane;
                    if (d == 0) *yp = f2bf(h);
                    else { const float gv = __uint_as_float(((unsigned)gt[tokl]) << 16), hfv = __uint_as_float(((unsigned)hq[tokl]) << 16); *yp = f2bf((hfv + h) * gelu_tanh_fast(gv)); } }
            }
        }
    }
    if (!FINAL) { float* ag = agg + ((size_t)line * 2 + d) * 2 * DLRU + cb * 64 + lane; ag[0] = aprod; ag[DLRU] = h; }
}
template <bool FINAL>
__device__ __forceinline__ void lru_unit(const In& in, const bf16* P, const bf16* WtL, int line, int cb, LAS unsigned char* wl, int lane, float* agg, const float* carry, bf16* Y) {
    int m0, pos0, len;
    if (line < 256) { m0 = (line >> 6) * SEQ + (line & 63) * GW; pos0 = 0; len = GW; } else { const int b = (line - 256) >> 2, q = (line - 256) & 3; m0 = T + b * CTXL + q * 64; pos0 = q * 64; len = CTXL; }
    LAS unsigned char* xsl = wl; LAS f32x2* abl = (LAS f32x2*)(wl + 9216);
    {
        const int cg = lane & 7, ch0 = cb * 64 + cg * 8;
        float cw[4][8], cbias[8];
#pragma unroll
        for (int tap = 0; tap < 4; ++tap) { const f32x4 w0 = *(const f32x4*)(in.conv_w + tap * DLRU + ch0), w1 = *(const f32x4*)(in.conv_w + tap * DLRU + ch0 + 4);
#pragma unroll
            for (int j = 0; j < 4; ++j) { cw[tap][j] = w0[j]; cw[tap][4 + j] = w1[j]; } }
        { const f32x4 b0 = *(const f32x4*)(in.conv_b + ch0), b1 = *(const f32x4*)(in.conv_b + ch0 + 4);
#pragma unroll
          for (int j = 0; j < 4; ++j) { cbias[j] = b0[j]; cbias[4 + j] = b1[j]; } }
#pragma unroll 1
        for (int ib = 0; ib < 2; ++ib) {
            u32x4 raw[4][4];
#pragma unroll
            for (int i4 = 0; i4 < 4; ++i4)
#pragma unroll
                for (int tap = 0; tap < 4; ++tap) { const int tok = (lane >> 3) + 8 * (ib * 4 + i4), q = pos0 + tok + tap - 2;
                    raw[i4][tap] = (u32x4){0u, 0u, 0u, 0u};
                    if (q >= 0 && q < len) raw[i4][tap] = *(const u32x4*)(P + (size_t)(m0 + tok + tap - 2) * PP + ch0); }
#pragma unroll
            for (int i4 = 0; i4 < 4; ++i4) { const int tok = (lane >> 3) + 8 * (ib * 4 + i4);
                float xs[8];
#pragma unroll
                for (int j = 0; j < 8; ++j) xs[j] = cbias[j];
#pragma unroll
                for (int tap = 0; tap < 4; ++tap) { float xv[8]; unpack8(raw[i4][tap], xv);
#pragma unroll
                    for (int j = 0; j < 8; ++j) xs[j] += cw[tap][j] * xv[j]; }
                *(LAS bf16x8*)(xsl + tok * 144 + cg * 16) = pack8(xs); }
        }
    }
    LDS_WAIT();
    lru_dir<FINAL, 0>(in, P, WtL, line, cb, m0, xsl, abl, lane, agg, carry, Y);
    lru_dir<FINAL, 1>(in, P, WtL, line, cb, m0, xsl, abl, lane, agg, carry, Y);
}

__device__ __forceinline__ int gla_row(int b, int n, int i) { return n < 4 ? T + b * CTXL + n * 64 + i : b * SEQ + (n - 4) * GW + i; }
__device__ __forceinline__ int gla_tok(int b, int n, int i) { return b * SEQ + i * GW + (n - 4); }
__device__ __forceinline__ float log_sigmoid_fast(float z) { return -(fmaxf(-z, 0.f) + __logf(1.0f + __expf(-fabsf(z)))); }
constexpr int GL_ALOW = 0, GL_WA = 4096, GL_BA = 12288, GL_LA = 12800  , GL_A = 47616  , GL_KD = 66048, GL_VT_P1 = 66048,
              GL_VT = 84480, GL_SC = 102912, GL_SS = 121344, GL_OT = 121856  , GL_END = 139264;
constexpr int GL_ST = 0;
static_assert(GL_ST + 256 * 72 * 2 <= GL_A, "state tile overlays the decay scratch only");
static_assert(GL_END <= SCR_BYTES, "gla scratch");
__device__ __forceinline__ void gla_decays(const In& in, const float* alow, int b, int h, int n, LAS unsigned char* lds, int tid) {
    LAS float* alowL = (LAS float*)(lds + GL_ALOW); LAS float* waL = (LAS float*)(lds + GL_WA); LAS float* baL = (LAS float*)(lds + GL_BA); LAS float* laL = (LAS float*)(lds + GL_LA);
    const int lane = tid & 63, wave = tid >> 6;
    if (tid < 256) { const int i = tid >> 2, part = tid & 3; *(LAS f32x4*)(alowL + i * 16 + part * 4) = *(const f32x4*)(alow + (size_t)gla_row(b, n, i) * RANK + part * 4); }
    { const int d = tid >> 8, r = (tid >> 4) & 15, c4 = (tid & 15) * 4; *(LAS f32x4*)(waL + (d * 16 + r) * 64 + c4) = *(const f32x4*)(in.gla_wa + ((size_t)d * RANK + r) * DGK + h * DK + c4); }
    if (tid < 128) baL[tid] = in.gla_ba[(tid >> 6) * DGK + h * DK + (tid & 63)];
    __syncthreads();
    { const int i = lane, k0 = wave * 8;
      float av[16];
#pragma unroll
      for (int r4 = 0; r4 < 4; ++r4) { const f32x4 t = *(const LAS f32x4*)(alowL + i * 16 + r4 * 4); av[r4 * 4] = t[0]; av[r4 * 4 + 1] = t[1]; av[r4 * 4 + 2] = t[2]; av[r4 * 4 + 3] = t[3]; }
#pragma unroll
      for (int d = 0; d < 2; ++d) { f32x4 z0 = *(const LAS f32x4*)(baL + d * 64 + k0), z1 = *(const LAS f32x4*)(baL + d * 64 + k0 + 4);
#pragma unroll
          for (int r = 0; r < RANK; ++r) { const f32x4 w0 = *(const LAS f32x4*)(waL + (d * 16 + r) * 64 + k0), w1 = *(const LAS f32x4*)(waL + (d * 16 + r) * 64 + k0 + 4); z0 += w0 * av[r]; z1 += w1 * av[r]; }
          f32x4 o0, o1;
#pragma unroll
          for (int j = 0; j < 4; ++j) { o0[j] = log_sigmoid_fast(z0[j]) * 0.0625f; o1[j] = log_sigmoid_fast(z1[j]) * 0.0625f; }
          *(LAS f32x4*)(laL + (d * 64 + i) * 68 + k0) = o0; *(LAS f32x4*)(laL + (d * 64 + i) * 68 + k0 + 4) = o1; } }
    __syncthreads();
    if (tid < 128) { const int d = tid >> 6, k = tid & 63; float v[64];
#pragma unroll
        for (int i = 0; i < 64; ++i) v[i] = laL[(d * 64 + i) * 68 + k];
        if (d == 0) {
#pragma unroll
            for (int i = 1; i < 64; ++i) v[i] += v[i - 1]; }
        else {
#pragma unroll
            for (int i = 62; i >= 0; --i) v[i] += v[i + 1]; }
#pragma unroll
        for (int i = 0; i < 64; ++i) laL[(d * 64 + i) * 68 + k] = v[i]; }
    __syncthreads();
}
#define GLA_LBAR() asm volatile("s_waitcnt lgkmcnt(0)\n\ts_barrier" ::: "memory")
__device__ __forceinline__ void gla_decays_pre(const f32x4 al, const f32x4 wav, const float bav, LAS unsigned char* lds, int tid) {
    LAS float* alowL = (LAS float*)(lds + GL_ALOW); LAS float* waT = (LAS float*)(lds + GL_WA); LAS float* baL = (LAS float*)(lds + GL_BA); LAS float* laL = (LAS float*)(lds + GL_LA);
    const int lane = tid & 63, wave = tid >> 6, fr = lane & 15, fq = lane >> 4;
    if (tid < 256) { const int i = tid >> 2, part = tid & 3; *(LAS f32x4*)(alowL + i * 16 + part * 4) = al; }
    { const int d = tid >> 8, r = (tid >> 4) & 15, c4 = (tid & 15) * 4;
#pragma unroll
      for (int j = 0; j < 4; ++j) waT[(d * 64 + c4 + j) * 16 + r] = wav[j]; }
    if (tid < 128) baL[tid] = bav;
    GLA_LBAR();
    { typedef short bf16x4 __attribute__((ext_vector_type(4)));
      const int d = wave >> 2, mt = wave & 3;
      const f32x4 av = *(const LAS f32x4*)(alowL + (mt * 16 + fr) * 16 + 4 * fq);
      u32x2 ahw, alw; ahw.x = pk2(av[0], av[1]); ahw.y = pk2(av[2], av[3]);
      alw.x = pk2(av[0] - __uint_as_float(ahw.x << 16), av[1] - __uint_as_float(ahw.x & 0xffff0000u)); alw.y = pk2(av[2] - __uint_as_float(ahw.y << 16), av[3] - __uint_as_float(ahw.y & 0xffff0000u));
      const bf16x4 ahi = __builtin_bit_cast(bf16x4, ahw), alo = __builtin_bit_cast(bf16x4, alw);
#pragma unroll
      for (int nt = 0; nt < 4; ++nt) {
          const f32x4 wv = *(const LAS f32x4*)(waT + (d * 64 + nt * 16 + fr) * 16 + 4 * fq);
          u32x2 bhw, blw; bhw.x = pk2(wv[0], wv[1]); bhw.y = pk2(wv[2], wv[3]);
          blw.x = pk2(wv[0] - __uint_as_float(bhw.x << 16), wv[1] - __uint_as_float(bhw.x & 0xffff0000u)); blw.y = pk2(wv[2] - __uint_as_float(bhw.y << 16), wv[3] - __uint_as_float(bhw.y & 0xffff0000u));
          const bf16x4 bhi = __builtin_bit_cast(bf16x4, bhw), blo = __builtin_bit_cast(bf16x4, blw);
          const float bias = baL[d * 64 + nt * 16 + fr];
          f32x4 acc = (f32x4){bias, bias, bias, bias};
          acc = __builtin_amdgcn_mfma_f32_16x16x16bf16_1k(ahi, bhi, acc, 0, 0, 0); acc = __builtin_amdgcn_mfma_f32_16x16x16bf16_1k(alo, bhi, acc, 0, 0, 0); acc = __builtin_amdgcn_mfma_f32_16x16x16bf16_1k(ahi, blo, acc, 0, 0, 0);
#pragma unroll
          for (int j = 0; j < 4; ++j) laL[(d * 64 + mt * 16 + 4 * fq + j) * 68 + nt * 16 + fr] = log_sigmoid_fast(acc[j]) * 0.0625f; } }
    GLA_LBAR();
    if (tid < 128) { const int d = tid >> 6, k = tid & 63; float v[64];
#pragma unroll
        for (int i = 0; i < 64; ++i) v[i] = laL[(d * 64 + i) * 68 + k];
        if (d == 0) {
#pragma unroll
            for (int i = 1; i < 64; ++i) v[i] += v[i - 1]; }
        else {
#pragma unroll
            for (int i = 62; i >= 0; --i) v[i] += v[i + 1]; }
#pragma unroll
        for (int i = 0; i < 64; ++i) laL[(d * 64 + i) * 68 + k] = v[i]; }
    GLA_LBAR();
}
__device__ __forceinline__ void gla_store_vT(const u32x4 r0, const u32x4 r1, LAS unsigned char* vt, int lane, int wave) {
    const unsigned w[8] = {r0.x, r0.y, r0.z, r0.w, r1.x, r1.y, r1.z, r1.w};
#pragma unroll
    for (int j = 0; j < 8; ++j) { *(LAS unsigned short*)(vt + ((wave * 16 + 2 * j) * 72 + lane) * 2) = (unsigned short)(w[j] & 0xffff); *(LAS unsigned short*)(vt + ((wave * 16 + 2 * j + 1) * 72 + lane) * 2) = (unsigned short)(w[j] >> 16); }
}
struct GlaPre { f32x4 al, wa; float ba; };
__device__ __forceinline__ void gla_fetch_pre(GlaPre& p, const In& in, const float* alow, int b, int h, int n, int tid) {
    { const int t8 = tid & 255; p.al = *(const f32x4*)(alow + (size_t)gla_row(b, n, t8 >> 2) * RANK + (t8 & 3) * 4); }
    { const int d = tid >> 8, r = (tid >> 4) & 15, c4 = (tid & 15) * 4; p.wa = *(const f32x4*)(in.gla_wa + ((size_t)d * RANK + r) * DGK + h * DK + c4); }
    { const int t7 = tid & 127; p.ba = in.gla_ba[(t7 >> 6) * DGK + h * DK + (t7 & 63)]; }
}
__device__ __forceinline__ void gla_pass1(const In& in, const GlaPre& cur, const bf16* P, int b, int h, int n, LAS unsigned char* lds, int tid, bf16* kvbuf, float* decbuf) {
    const int lane = tid & 63, w = __builtin_amdgcn_readfirstlane(tid >> 6), fr = lane & 15, fq = lane >> 4;
    const int uid = (b * HEADS + h) * 68 + n;
    const bf16* rp = P + (size_t)gla_row(b, n, lane) * PP;
    const u32x4 kraw = *(const u32x4*)(rp + 1280 + h * DK + w * 8), vr0 = *(const u32x4*)(rp + 1536 + h * DV + w * 16), vr1 = *(const u32x4*)(rp + 1536 + h * DV + w * 16 + 8);
    gla_decays_pre(cur.al, cur.wa, cur.ba, lds, tid);
    LAS float* laL = (LAS float*)(lds + GL_LA);
    { const int i = lane, k0 = w * 8; float kv[8]; unpack8(kraw, kv);
#pragma unroll
      for (int d = 0; d < 2; ++d) { const int ie = d == 0 ? 63 : 0;
          const f32x4 bc0 = *(const LAS f32x4*)(laL + (d * 64 + i) * 68 + k0), bc1 = *(const LAS f32x4*)(laL + (d * 64 + i) * 68 + k0 + 4);
          const f32x4 bt0 = *(const LAS f32x4*)(laL + (d * 64 + ie) * 68 + k0), bt1 = *(const LAS f32x4*)(laL + (d * 64 + ie) * 68 + k0 + 4);
#pragma unroll
          for (int j = 0; j < 8; ++j) { const float bc = j < 4 ? bc0[j & 3] : bc1[j & 3], bt = j < 4 ? bt0[j & 3] : bt1[j & 3];
              *(LAS unsigned short*)(lds + GL_A + ((d * 64 + k0 + j) * 72 + i) * 2) = f2bf(kv[j] * __expf(bt - bc)); } } }
    gla_store_vT(vr0, vr1, lds + GL_VT_P1, lane, w);
    if (tid < 128) { const int d = tid >> 6, k = tid & 63; decbuf[((size_t)uid * 2 + d) * 64 + k] = __expf(laL[(d * 64 + (d == 0 ? 63 : 0)) * 68 + k]); }
    __syncthreads();
    { const int d = w >> 2, mt = w & 3;
      bf16x8 af[2];
#pragma unroll
      for (int ks = 0; ks < 2; ++ks) af[ks] = *(const LAS bf16x8*)(lds + GL_A + ((d * 64 + mt * 16 + fr) * 72 + ks * 32 + fq * 8) * 2);
#pragma unroll
      for (int nt = 0; nt < 8; ++nt) { f32x4 acc = (f32x4){0.f, 0.f, 0.f, 0.f};
#pragma unroll
          for (int ks = 0; ks < 2; ++ks) { const bf16x8 bfv = *(const LAS bf16x8*)(lds + GL_VT_P1 + ((nt * 16 + fr) * 72 + ks * 32 + fq * 8) * 2); acc = __builtin_amdgcn_mfma_f32_16x16x32_bf16(af[ks], bfv, acc, 0, 0, 0); }
          u32x2 o; o.x = pk2(acc[0], acc[1]); o.y = pk2(acc[2], acc[3]); *(u32x2*)(kvbuf + (((size_t)uid * 2 + d) * DV + nt * 16 + fr) * DK + mt * 16 + 4 * fq) = o; } }
    __syncthreads();
}
__device__ __forceinline__ void gla_final(const In& in, const GlaPre& cur, const bf16* P, int b, int h, int c, LAS unsigned char* lds, int tid, const bf16* Sbuf, bf16* Y) {
    const int lane = tid & 63, w = __builtin_amdgcn_readfirstlane(tid >> 6), fr = lane & 15, fq = lane >> 4, n = c + 4;
    const int uidL = (b * HEADS + h) * 64 + c;
    const bf16* rp = P + (size_t)gla_row(b, n, lane) * PP;
    const u32x4 qraw = *(const u32x4*)(rp + 1024 + h * DK + w * 8), kraw = *(const u32x4*)(rp + 1280 + h * DK + w * 8), vr0 = *(const u32x4*)(rp + 1536 + h * DV + w * 16), vr1 = *(const u32x4*)(rp + 1536 + h * DV + w * 16 + 8);
    const int oi = tid >> 3, opart = tid & 7; const size_t om = (size_t)gla_row(b, n, oi), otok = (size_t)gla_tok(b, n, oi);
    const u32x4 gr0 = *(const u32x4*)(P + om * PP + 2048 + h * DV + opart * 16), gr1 = *(const u32x4*)(P + om * PP + 2048 + h * DV + opart * 16 + 8);
    u32x4 sreg[4];
    { const u32x4* sg = (const u32x4*)(Sbuf + (size_t)uidL * 2 * DV * DK) + tid * 4;
#pragma unroll
      for (int i4 = 0; i4 < 4; ++i4) sreg[i4] = sg[i4]; }
    gla_decays_pre(cur.al, cur.wa, cur.ba, lds, tid);
    LAS float* laL = (LAS float*)(lds + GL_LA);
    { const int i = lane, k0 = w * 8; float qv[8], kv[8]; unpack8(qraw, qv); unpack8(kraw, kv);
#pragma unroll
      for (int d = 0; d < 2; ++d) { float qd[8], kd[8];
          const f32x4 bc0 = *(const LAS f32x4*)(laL + (d * 64 + i) * 68 + k0), bc1 = *(const LAS f32x4*)(laL + (d * 64 + i) * 68 + k0 + 4);
#pragma unroll
          for (int j = 0; j < 8; ++j) { const float bc = j < 4 ? bc0[j & 3] : bc1[j & 3]; qd[j] = qv[j] * 0.125f * __expf(bc); kd[j] = kv[j] * __expf(-bc); }
          *(LAS bf16x8*)(lds + GL_A + ((d * 64 + i) * 72 + k0) * 2) = pack8(qd); *(LAS bf16x8*)(lds + GL_KD + ((d * 64 + i) * 72 + k0) * 2) = pack8(kd); } }
    gla_store_vT(vr0, vr1, lds + GL_VT, lane, w);
    __syncthreads();
    { const int srow = tid >> 1, shalf = tid & 1;
#pragma unroll
      for (int i4 = 0; i4 < 4; ++i4) *(LAS u32x4*)(lds + GL_ST + (srow * 72 + shalf * 32 + i4 * 8) * 2) = sreg[i4]; }
    { const int d = w >> 2, mt = w & 3;
      bf16x8 af[2];
#pragma unroll
      for (int ks = 0; ks < 2; ++ks) af[ks] = *(const LAS bf16x8*)(lds + GL_A + ((d * 64 + mt * 16 + fr) * 72 + ks * 32 + fq * 8) * 2);
#pragma unroll
      for (int nt = 0; nt < 4; ++nt) { f32x4 acc = (f32x4){0.f, 0.f, 0.f, 0.f};
#pragma unroll
          for (int ks = 0; ks < 2; ++ks) { const bf16x8 bfv = *(const LAS bf16x8*)(lds + GL_KD + ((d * 64 + nt * 16 + fr) * 72 + ks * 32 + fq * 8) * 2); acc = __builtin_amdgcn_mfma_f32_16x16x32_bf16(af[ks], bfv, acc, 0, 0, 0); }
#pragma unroll
          for (int r = 0; r < 4; ++r) { const int i = mt * 16 + 4 * fq + r, j = nt * 16 + fr; const bool keep = d == 0 ? (j <= i) : (j >= i);
              *(LAS unsigned short*)(lds + GL_SC + ((d * 64 + i) * 72 + j) * 2) = f2bf(keep ? acc[r] : 0.f); } } }
    const int mt = w & 3, nh = w >> 2;
    __syncthreads();
    f32x4 acc[4];
#pragma unroll
    for (int q = 0; q < 4; ++q) acc[q] = (f32x4){0.f, 0.f, 0.f, 0.f};
#pragma unroll
    for (int d = 0; d < 2; ++d)
#pragma unroll
        for (int ks = 0; ks < 2; ++ks) {
            const bf16x8 a1 = *(const LAS bf16x8*)(lds + GL_SC + ((d * 64 + mt * 16 + fr) * 72 + ks * 32 + fq * 8) * 2);
            const bf16x8 a2 = *(const LAS bf16x8*)(lds + GL_A + ((d * 64 + mt * 16 + fr) * 72 + ks * 32 + fq * 8) * 2);
#pragma unroll
            for (int q = 0; q < 4; ++q) { const int nt = nh * 4 + q;
                const bf16x8 b1 = *(const LAS bf16x8*)(lds + GL_VT + ((nt * 16 + fr) * 72 + ks * 32 + fq * 8) * 2);
                acc[q] = __builtin_amdgcn_mfma_f32_16x16x32_bf16(a1, b1, acc[q], 0, 0, 0);
                const bf16x8 b2 = *(const LAS bf16x8*)(lds + GL_ST + ((d * 128 + nt * 16 + fr) * 72 + ks * 32 + fq * 8) * 2);
                acc[q] = __builtin_amdgcn_mfma_f32_16x16x32_bf16(a2, b2, acc[q], 0, 0, 0); } }
    LAS float* ssL = (LAS float*)(lds + GL_SS);
#pragma unroll
    for (int r = 0; r < 4; ++r) { float ss = 0.f;
#pragma unroll
        for (int q = 0; q < 4; ++q) ss += acc[q][r] * acc[q][r];
        ss += dppf<DPP_XOR1>(ss); ss += dppf<DPP_XOR2>(ss); ss += dppf<DPP_XOR7>(ss); ss += dppf<DPP_XOR15>(ss);
        if (fr == 0) ssL[nh * 64 + mt * 16 + 4 * fq + r] = ss; }
    __syncthreads();
#pragma unroll
    for (int r = 0; r < 4; ++r) { const int i = mt * 16 + 4 * fq + r; const float rs = rsqrtf((ssL[i] + ssL[64 + i]) * (1.0f / DV) + RMS_EPS);
#pragma unroll
        for (int q = 0; q < 4; ++q) *(LAS unsigned short*)(lds + GL_OT + (i * 136 + (nh * 4 + q) * 16 + fr) * 2) = f2bf(acc[q][r] * rs); }
    __syncthreads();
    { float ov[8], gv[8]; u32x4 o4[2];
#pragma unroll
      for (int half = 0; half < 2; ++half) { unpack8(*(const LAS u32x4*)(lds + GL_OT + (oi * 136 + opart * 16 + half * 8) * 2), ov); unpack8(half == 0 ? gr0 : gr1, gv);
          const int cc = h * DV + opart * 16 + half * 8; const f32x4 n0 = *(const f32x4*)(in.gla_norm_g + cc), n1 = *(const f32x4*)(in.gla_norm_g + cc + 4);
          float yv[8];
#pragma unroll
          for (int j = 0; j < 8; ++j) yv[j] = ov[j] * (j < 4 ? n0[j & 3] : n1[j & 3]) * (gv[j] * fast_sigmoid(gv[j]));
          o4[half] = __builtin_bit_cast(u32x4, pack8(yv)); }
      bf16* yp = Y + otok * D + DLRU + h * DV + opart * 16; *(u32x4*)yp = o4[0]; *(u32x4*)(yp + 8) = o4[1]; }
    __syncthreads();
}

#define XB_TMO      128
#define XB_XCNT(j)  (256  + 64 * (j))
#define XB_XSUB(j)  (1280 + 64 * (j))
#define XB_XGEN(j)  (2304 + 64 * (j))
#define XB_TOP      3328
#define XB_TOPGEN   3392
#define XCD_BAR_WORDS 3456
#define XB_SPIN_CAP (1u << 22)
constexpr int CW_BAR = 4096;
static_assert((CW_BAR + XCD_BAR_WORDS) * 4 <= (int)CTL_ZERO_BYTES, "barrier words inside the memset region");
__device__ __forceinline__ unsigned xb_ld(unsigned* p)              { return __hip_atomic_load(p, __ATOMIC_RELAXED, __HIP_MEMORY_SCOPE_AGENT); }
__device__ __forceinline__ unsigned xb_add(unsigned* p, unsigned v) { return __hip_atomic_fetch_add(p, v, __ATOMIC_RELAXED, __HIP_MEMORY_SCOPE_AGENT); }
__device__ __forceinline__ unsigned xb_xcc_id() { return (unsigned)__builtin_amdgcn_s_getreg((3 << 11) | 20) & 0xFu; }
#define XB_SPIN(cond, bar) do { unsigned _sp = 0; while (cond) { __builtin_amdgcn_s_sleep(1); \
    if ((++_sp & 255u) == 0u) { if (xb_ld(&(bar)[XB_TMO])) break; if (_sp > XB_SPIN_CAP) { atomicAdd(&(bar)[XB_TMO], 1u); break; } } } } while (0)
struct XcdBarrier { unsigned* bar; unsigned x; volatile LAS unsigned* st; };
__device__ __forceinline__ XcdBarrier xcd_barrier_post(unsigned* bar, volatile LAS unsigned* st) {
    XcdBarrier b; b.bar = bar; b.x = xb_xcc_id(); b.st = st;
    if (threadIdx.x == 0) (void)xb_add(&bar[XB_XCNT(b.x)], 1u);
    return b;
}
__device__ __forceinline__ void xcd_barrier_complete(unsigned* bar, unsigned x, unsigned& nloc, unsigned& nx) {
    const unsigned G = gridDim.x * gridDim.y * gridDim.z;
    unsigned sum, cnt, mine, sp = 0u;
    for (;;) {
        sum = 0u; cnt = 0u; mine = 0u;
#pragma unroll
        for (unsigned j = 0; j < 16; ++j) { const unsigned c = xb_ld(&bar[XB_XCNT(j)]); sum += c; cnt += (c > 0u) ? 1u : 0u; mine = (j == x) ? c : mine; }
        if (sum == G) break;
        __builtin_amdgcn_s_sleep(1);
        if ((++sp & 255u) == 0u) { if (xb_ld(&bar[XB_TMO])) break; if (sp > XB_SPIN_CAP) { atomicAdd(&bar[XB_TMO], 1u); break; } }
    }
    nloc = mine > 0u ? mine : 1u; nx = cnt > 0u ? cnt : 1u;
}
__device__ __forceinline__ void xcd_barrier(const XcdBarrier& b) {
    asm volatile("s_waitcnt vmcnt(0)" ::: "memory");
    __syncthreads();
    if (threadIdx.x == 0) {
        unsigned* bar = b.bar;
        __builtin_amdgcn_s_waitcnt(0);
        unsigned nloc = b.st[0], nx = b.st[1];
        if (nloc == 0u) { xcd_barrier_complete(bar, b.x, nloc, nx); b.st[0] = nloc; b.st[1] = nx; }
        const unsigned old = xb_add(&bar[XB_XSUB(b.x)], 1u);
        const unsigned gen = old / nloc;
        if (old + 1u == (gen + 1u) * nloc) {
            __builtin_amdgcn_fence(__ATOMIC_RELEASE, "agent");
            asm volatile("s_waitcnt vmcnt(0)" ::: "memory");
            const unsigned og = xb_add(&bar[XB_TOP], 1u);
            const unsigned tg = og / nx;
            if (og + 1u == (tg + 1u) * nx) xb_add(&bar[XB_TOPGEN], 1u);
            else XB_SPIN(xb_ld(&bar[XB_TOPGEN]) == tg, bar);
            __builtin_amdgcn_fence(__ATOMIC_ACQUIRE, "agent");
            xb_add(&bar[XB_XGEN(b.x)], 1u);
            asm volatile("s_waitcnt vmcnt(0)" ::: "memory");
        } else {
            XB_SPIN(xb_ld(&bar[XB_XGEN(b.x)]) == gen, bar);
            __builtin_amdgcn_fence(__ATOMIC_ACQUIRE, "agent");
            asm volatile("s_waitcnt vmcnt(0)" ::: "memory");
        }
    }
    __syncthreads();
}

__device__ __forceinline__ void ada_item(const In& in, float* mod, int item, LAS unsigned char* lds, int tid) {
    LAS float* sv = (LAS float*)lds; LAS float* red = (LAS float*)(lds + 20480);
    const int lane = tid & 63, wave = tid >> 6;
    for (int idx = tid; idx < 5 * D; idx += NTHR) { const int r = idx >> 10, k = idx & 1023; const float cv = r < 4 ? in.c[r * D + k] : in.c_ctx[k]; sv[idx] = cv * fast_sigmoid(cv); }
    __syncthreads();
    const int n0 = item * 32, col = lane & 31, kpar = lane >> 5;
    float acc[5] = {0.f, 0.f, 0.f, 0.f, 0.f};
#pragma unroll 16
    for (int i = 0; i < 64; ++i) { const int k = wave * 128 + 2 * i + kpar; const float w = in.w_ada[(size_t)k * 6144 + n0 + col];
#pragma unroll
        for (int r = 0; r < 5; ++r) acc[r] += sv[r * D + k] * w; }
#pragma unroll
    for (int r = 0; r < 5; ++r) red[((wave * 2 + kpar) * 5 + r) * 32 + col] = acc[r];
    __syncthreads();
    if (tid < 160) { const int r = tid >> 5, c2 = tid & 31; float sum = 0.f;
#pragma unroll
        for (int p = 0; p < 16; ++p) sum += red[(p * 5 + r) * 32 + c2];
        mod[r * 6144 + n0 + c2] = sum + in.b_ada[n0 + c2]; }
    __syncthreads();
}
template <int NR>
__device__ __forceinline__ void mod_rows(const float* xr, const float* md, bf16* up, int lane) {
    f32x4 sh[4], sc[4], xv[NR][4];
#pragma unroll
    for (int r = 0; r < NR; ++r)
#pragma unroll
        for (int j = 0; j < 4; ++j) xv[r][j] = __builtin_nontemporal_load((const f32x4*)(xr + (size_t)r * D + 4 * lane + 256 * j));
#pragma unroll
    for (int j = 0; j < 4; ++j) { sh[j] = *(const f32x4*)(md + 4 * lane + 256 * j); sc[j] = *(const f32x4*)(md + 1024 + 4 * lane + 256 * j) + 1.0f; }
#pragma unroll
    for (int r = 0; r < NR; ++r)
#pragma unroll
        for (int j = 0; j < 4; ++j) { const f32x4 uv = xv[r][j] * sc[j] + sh[j]; u32x2 o; o.x = pk2(uv[0], uv[1]); o.y = pk2(uv[2], uv[3]); *(u32x2*)(up + (size_t)r * D + 4 * lane + 256 * j) = o; }
}
__device__ __forceinline__ void final_rows(const In& in, const bf16* z, float* zo, const float* mod, const unsigned char* ybuf, int m0, int mstep, int lane) {
    f32x4 l1g[4], l1b[4], l2g[4], l2b[4]; u32x2 zr[4]; unsigned yr[4][4];
#pragma unroll
    for (int j = 0; j < 4; ++j) { const int k = 4 * lane + 256 * j; l1g[j] = *(const f32x4*)(in.ln1_g + k); l1b[j] = *(const f32x4*)(in.ln1_b + k); l2g[j] = *(const f32x4*)(in.ln2_g + k); l2b[j] = *(const f32x4*)(in.ln2_b + k); }
#pragma unroll
    for (int j = 0; j < 4; ++j) { zr[j] = *(const u32x2*)(z + (size_t)m0 * pg8::ZP + 4 * lane + 256 * j);
#pragma unroll
        for (int t = 0; t < 4; ++t) yr[j][t] = __builtin_nontemporal_load((const unsigned*)(ybuf + ((size_t)m0 * 4 + t) * D + 4 * lane + 256 * j)); }
#pragma unroll 1
    for (int m = m0; m < T; m += mstep) {
        const int mn = (m + mstep < T) ? m + mstep : m;
        u32x2 zn[4]; unsigned yn[4][4]; f32x4 gg[4], v[4];
        const float* g2 = mod + (m / SEQ) * 6144 + 5120;
#pragma unroll
        for (int j = 0; j < 4; ++j) { zn[j] = *(const u32x2*)(z + (size_t)mn * pg8::ZP + 4 * lane + 256 * j);
#pragma unroll
            for (int t = 0; t < 4; ++t) yn[j][t] = __builtin_nontemporal_load((const unsigned*)(ybuf + ((size_t)mn * 4 + t) * D + 4 * lane + 256 * j));
            gg[j] = *(const f32x4*)(g2 + 4 * lane + 256 * j); }
        float s = 0.f;
#pragma unroll
        for (int j = 0; j < 4; ++j) { v[j] = (f32x4){__uint_as_float(zr[j].x << 16), __uint_as_float(zr[j].x & 0xffff0000u), __uint_as_float(zr[j].y << 16), __uint_as_float(zr[j].y & 0xffff0000u)}; s += (v[j][0] + v[j][1]) + (v[j][2] + v[j][3]); }
        float mean = wave_sum(s) * (1.0f / D), q = 0.f;
#pragma unroll
        for (int j = 0; j < 4; ++j) { v[j] = v[j] - mean; q += (v[j][0] * v[j][0] + v[j][1] * v[j][1]) + (v[j][2] * v[j][2] + v[j][3] * v[j][3]); }
        float rstd = rsqrtf(wave_sum(q) * (1.0f / D) + LN_EPS);
        s = 0.f;
#pragma unroll
        for (int j = 0; j < 4; ++j) { const f32x4 x1 = v[j] * rstd * l1g[j] + l1b[j];
            f32x4 mo = (f32x4){0.f, 0.f, 0.f, 0.f};
#pragma unroll
            for (int t = 0; t < 4; ++t) { const f32x2 lo = __builtin_amdgcn_cvt_pk_f32_fp8((int)yr[j][t], false), hi = __builtin_amdgcn_cvt_pk_f32_fp8((int)yr[j][t], true);
                mo[0] += lo[0]; mo[1] += lo[1]; mo[2] += hi[0]; mo[3] += hi[1]; }
            v[j] = x1 * ALPHA + gg[j] * (mo * (1.0f / pg8::YSCALE)); s += (v[j][0] + v[j][1]) + (v[j][2] + v[j][3]); }
        mean = wave_sum(s) * (1.0f / D); q = 0.f;
#pragma unroll
        for (int j = 0; j < 4; ++j) { v[j] = v[j] - mean; q += (v[j][0] * v[j][0] + v[j][1] * v[j][1]) + (v[j][2] * v[j][2] + v[j][3] * v[j][3]); }
        rstd = rsqrtf(wave_sum(q) * (1.0f / D) + LN_EPS);
#pragma unroll
        for (int j = 0; j < 4; ++j) { *(f32x4*)(zo + (size_t)m * D + 4 * lane + 256 * j) = v[j] * rstd * l2g[j] + l2b[j]; zr[j] = zn[j];
#pragma unroll
            for (int t = 0; t < 4; ++t) yr[j][t] = yn[j][t]; }
    }
}
constexpr int RT_WP = 1032  , RT_WH = 0, RT_WL = RT_WH + NE * RT_WP * 2, RT_GB = RT_WL + NE * RT_WP * 2  ,
              RT_ST = RT_GB + 8192  , RT_TAB = LDSTOK_OFF, RT_LCNT = RT_TAB + 64 * 4 * 8  , RT_BASE = RT_LCNT + 128;
static_assert(RT_ST + 1024 <= SCR_BYTES && RT_BASE + 128 <= LDS_BYTES, "route scratch");
__device__ __forceinline__ void route_stage_w(const unsigned char* img, LAS unsigned char* lds, int tid) {
    constexpr int N16 = (RT_GB - RT_WH) / 16, PER = (N16 + NTHR - 1) / NTHR;
    u32x4 r[PER];
#pragma unroll
    for (int i = 0; i < PER; ++i) { const int idx = tid + i * NTHR; r[i] = *(const u32x4*)(img + (size_t)(idx < N16 ? idx : 0) * 16); }
#pragma unroll
    for (int i = 0; i < PER; ++i) { const int idx = tid + i * NTHR; if (idx < N16) *(LAS u32x4*)(lds + RT_WH + idx * 16) = r[i]; }
}
__device__ __forceinline__ void route_tile(const In& in, const bf16* z, const float* mod, unsigned char* H, float* tok_w, int* cnt, int* list, int tile, LAS unsigned char* lds, int tid) {
    const int lane = tid & 63, wave = __builtin_amdgcn_readfirstlane(tid >> 6), fr = lane & 15, fq = lane >> 4, g = wave >> 1, kh = wave & 1;
    LAS float* GB = (LAS float*)(lds + RT_GB); LAS float* ST = (LAS float*)(lds + RT_ST); LAS int* tab = (LAS int*)(lds + RT_TAB); LAS int* lcnt = (LAS int*)(lds + RT_LCNT); LAS int* gbase = (LAS int*)(lds + RT_BASE);
    const int m = tile * 64 + g * 16 + fr, kb = 512 * kh + 8 * fq;
    u32x4 zr[16];
#pragma unroll
    for (int ks = 0; ks < 16; ++ks) zr[ks] = *(const u32x4*)(z + (size_t)m * pg8::ZP + kb + 32 * ks);
    if (tid < NE) lcnt[tid] = 0;
    if (tid < 256) { const float* md0 = mod + ((tile * 64) / SEQ) * 6144; const int k = tid * 4; const f32x4 gg = *(const f32x4*)(in.ln1_g + k), bb = *(const f32x4*)(in.ln1_b + k), sc = *(const f32x4*)(md0 + 4096 + k) + 1.0f, sh = *(const f32x4*)(md0 + 3072 + k);
        *(LAS f32x4*)(GB + k) = gg * sc; *(LAS f32x4*)(GB + D + k) = bb * sc + sh; }
    float s1 = 0.f, s2 = 0.f;
#pragma unroll
    for (int ks = 0; ks < 16; ++ks) { float x[8]; unpack8(zr[ks], x);
#pragma unroll
        for (int j = 0; j < 8; ++j) { s1 += x[j]; s2 += x[j] * x[j]; } }
    { auto r = __builtin_amdgcn_permlane32_swap(__float_as_uint(s1), __float_as_uint(s1), false, false); s1 = __uint_as_float(r[0]) + __uint_as_float(r[1]);
      r = __builtin_amdgcn_permlane16_swap(__float_as_uint(s1), __float_as_uint(s1), false, false); s1 = __uint_as_float(r[0]) + __uint_as_float(r[1]);
      r = __builtin_amdgcn_permlane32_swap(__float_as_uint(s2), __float_as_uint(s2), false, false); s2 = __uint_as_float(r[0]) + __uint_as_float(r[1]);
      r = __builtin_amdgcn_permlane16_swap(__float_as_uint(s2), __float_as_uint(s2), false, false); s2 = __uint_as_float(r[0]) + __uint_as_float(r[1]); }
    if (fq == 0) { ST[((g * 2 + kh) * 16 + fr) * 2] = s1; ST[((g * 2 + kh) * 16 + fr) * 2 + 1] = s2; }
    __syncthreads();
    const float t1 = ST[((g * 2) * 16 + fr) * 2] + ST[((g * 2 + 1) * 16 + fr) * 2], t2 = ST[((g * 2) * 16 + fr) * 2 + 1] + ST[((g * 2 + 1) * 16 + fr) * 2 + 1];
    const float mean = t1 * (1.0f / D), rstd = rsqrtf(fmaxf(t2 * (1.0f / D) - mean * mean, 0.f) + LN_EPS);
    f32x4 acc[2] = {(f32x4){0.f, 0.f, 0.f, 0.f}, (f32x4){0.f, 0.f, 0.f, 0.f}};
    const LAS unsigned short* whp = (const LAS unsigned short*)(lds + RT_WH) + fr * RT_WP + kb; const LAS unsigned short* wlp = (const LAS unsigned short*)(lds + RT_WL) + fr * RT_WP + kb;
#pragma unroll
    for (int ks = 0; ks < 16; ++ks) { float x[8]; unpack8(zr[ks], x);
        const int k = kb + 32 * ks; const f32x4 g0 = *(const LAS f32x4*)(GB + k), g1 = *(const LAS f32x4*)(GB + k + 4), b0 = *(const LAS f32x4*)(GB + D + k), b1 = *(const LAS f32x4*)(GB + D + k + 4);
        float h[8], hl[8];
#pragma unroll
        for (int j = 0; j < 4; ++j) { h[j] = (x[j] - mean) * rstd * g0[j] + b0[j]; h[4 + j] = (x[4 + j] - mean) * rstd * g1[j] + b1[j]; }
        u32x2 o; o.x = 0u; o.y = 0u;
        o.x = __builtin_amdgcn_cvt_pk_fp8_f32(h[0], h[1], o.x, false); o.x = __builtin_amdgcn_cvt_pk_fp8_f32(h[2], h[3], o.x, true); o.y = __builtin_amdgcn_cvt_pk_fp8_f32(h[4], h[5], o.y, false); o.y = __builtin_amdgcn_cvt_pk_fp8_f32(h[6], h[7], o.y, true);
        *(u32x2*)(H + (size_t)m * D + k) = o;
        const bf16x8 ahi = pack8(h);
        { float hf[8]; unpack8(__builtin_bit_cast(u32x4, ahi), hf);
#pragma unroll
          for (int j = 0; j < 8; ++j) hl[j] = h[j] - hf[j]; }
        const bf16x8 alo = pack8(hl);
#pragma unroll
        for (int nt = 0; nt < 2; ++nt) { const bf16x8 bh = *(const LAS bf16x8*)(whp + nt * 16 * RT_WP + 32 * ks), bl = *(const LAS bf16x8*)(wlp + nt * 16 * RT_WP + 32 * ks);
            acc[nt] = __builtin_amdgcn_mfma_f32_16x16x32_bf16(ahi, bh, acc[nt], 0, 0, 0); acc[nt] = __builtin_amdgcn_mfma_f32_16x16x32_bf16(alo, bh, acc[nt], 0, 0, 0); acc[nt] = __builtin_amdgcn_mfma_f32_16x16x32_bf16(ahi, bl, acc[nt], 0, 0, 0); } }
    __syncthreads();
    LAS float* PL = GB + g * 512;
    if (kh == 1) {
#pragma unroll
        for (int nt = 0; nt < 2; ++nt)
#pragma unroll
            for (int j = 0; j < 4; ++j) PL[(4 * fq + j) * 32 + nt * 16 + fr] = acc[nt][j]; }
    __syncthreads();
    if (kh == 0) {
#pragma unroll
        for (int nt = 0; nt < 2; ++nt)
#pragma unroll
            for (int j = 0; j < 4; ++j) PL[(4 * fq + j) * 32 + nt * 16 + fr] += acc[nt][j];
        LDS_WAIT();
        const int row = lane >> 2, qd = lane & 3; float lv[8];
        { const f32x4 a0 = *(const LAS f32x4*)(PL + row * 32 + qd * 8), a1 = *(const LAS f32x4*)(PL + row * 32 + qd * 8 + 4); const f32x4 c0 = *(const f32x4*)(in.b_router + qd * 8), c1 = *(const f32x4*)(in.b_router + qd * 8 + 4);
#pragma unroll
          for (int j = 0; j < 4; ++j) { lv[j] = a0[j] + c0[j]; lv[4 + j] = a1[j] + c1[j]; } }
        int ei[4]; float ev[4];
#pragma unroll
        for (int t = 0; t < 4; ++t) { float bv = lv[0]; int bi = 0;
#pragma unroll
            for (int j = 1; j < 8; ++j) if (lv[j] > bv) { bv = lv[j]; bi = j; }
            bi += qd * 8;
            { const float pv = dppf<DPP_XOR1>(bv); const int pi = __builtin_amdgcn_update_dpp(0, bi, DPP_XOR1, 0xF, 0xF, true); if (pv > bv || (pv == bv && pi < bi)) { bv = pv; bi = pi; } }
            { const float pv = dppf<DPP_XOR2>(bv); const int pi = __builtin_amdgcn_update_dpp(0, bi, DPP_XOR2, 0xF, 0xF, true); if (pv > bv || (pv == bv && pi < bi)) { bv = pv; bi = pi; } }
            ei[t] = bi; ev[t] = bv;
#pragma unroll
            for (int j = 0; j < 8; ++j) if (bi == qd * 8 + j) lv[j] = -3.0e38f; }
        float wsum = 0.f, wj[4];
#pragma unroll
        for (int t = 0; t < 4; ++t) { wj[t] = __expf(ev[t] - ev[0]); wsum += wj[t]; }
        const float inv = 1.0f / wsum;
        { const int e = qd == 0 ? ei[0] : qd == 1 ? ei[1] : qd == 2 ? ei[2] : ei[3]; const float w = (qd == 0 ? wj[0] : qd == 1 ? wj[1] : qd == 2 ? wj[2] : wj[3]) * inv; const int rl = g * 16 + row;
          const int rank = __hip_atomic_fetch_add(&lcnt[e], 1, __ATOMIC_RELAXED, __HIP_MEMORY_SCOPE_WORKGROUP); tab[(rl * 4 + qd) * 2] = e; tab[(rl * 4 + qd) * 2 + 1] = rank; tok_w[(size_t)(tile * 64 + rl) * 4 + qd] = w; }
    }
    __syncthreads();
    if (tid < NE) gbase[tid] = atomicAdd(&cnt[tid], lcnt[tid]);
    __syncthreads();
    if (tid < 256) { const int e = tab[tid * 2], rank = tab[tid * 2 + 1]; list[(size_t)e * T + gbase[e] + rank] = (tile * 64 + (tid >> 2)) * 4 + (tid & 3); }
    __syncthreads();
}

__global__ void __launch_bounds__(NTHR, 2) mega(Args args) {
    extern __shared__ __attribute__((aligned(16))) unsigned char lds_raw[];
    LAS unsigned char* lds = (LAS unsigned char*)lds_raw;
    const In& in = args.in; unsigned char* ws = args.ws;
    const int tid = threadIdx.x, lane = tid & 63, wave = __builtin_amdgcn_readfirstlane(tid >> 6);
    const int G = gridDim.x, bx = blockIdx.x;
    const int vcu = (G % 8 == 0) ? (bx % 8) * (G / 8) + bx / 8 : bx;
    const int gw = vcu * NWAVES + wave, NGW = G * NWAVES;
    const unsigned ph = args.phases;
    for (int u = tid; u < 128; u += NTHR) ((LAS unsigned*)(lds + LDSCTL_OFF))[u] = 0u;
    __syncthreads();
    XcdBarrier bar; bar.bar = (unsigned*)(ws + WS_CTL) + CW_BAR; bar.x = 0; bar.st = nullptr;
    if (ph & (ph - 1)) bar = xcd_barrier_post((unsigned*)(ws + WS_CTL) + CW_BAR, (volatile LAS unsigned*)(lds + LDSCTL_OFF) + 8);
#define PHASE_END(p) do { if (ph >> ((p) + 1)) xcd_barrier(bar); } while (0)
    bf16* WtIn = (bf16*)(ws + WS_WTIN); bf16* WtOut = (bf16*)(ws + WS_WTOUT); unsigned char* WGU = ws + WS_WGU; unsigned char* WDN = ws + WS_WDN; bf16* WtL = (bf16*)(ws + WS_WTL);
    bf16* U = (bf16*)(ws + WS_U); bf16* P = (bf16*)(ws + WS_P); float* alow = (float*)(ws + WS_ALOW); bf16* Y = (bf16*)(ws + WS_Y); unsigned char* H = ws + WS_H;
    unsigned char* ACT = ws + WS_ACT; unsigned char* YBUF = ws + WS_YBUF; float* mod = (float*)(ws + WS_MOD);
    const int* cnt = (const int*)(ws + WS_CTL); const int* list = (const int*)(ws + WS_LIST); const float* tok_w = (const float*)(ws + WS_ROUTE_W);
    LAS int* tb = (LAS int*)(lds + LDSTBL_OFF); LAS int* cntl = tb + 40;
    float* agg = (float*)(ws + WS_AGG); float* carry = (float*)(ws + WS_CARRY); float* decbuf = (float*)(ws + WS_DEC); bf16* kvbuf = (bf16*)(ws + WS_KV);
    bf16* Sbuf = (bf16*)args.out;

    if (ph & (1u << PH_WEXP)) {
        LAS float* scr = (LAS float*)(lds + wave * 16384);
        for (int it = gw; it < 96 * 512; it += NGW) {
            const int mi = it >> 9, r = it & 511, kb = r >> 5, nb = r & 31, n0 = nb * 32, type = mi >> 5, e = mi & 31;
            const float* W; unsigned char* dst;
            if (type == 0) { W = in.w_gate + (size_t)e * D * D; dst = WGU + ((size_t)e * 2048 + (n0 >> 7) * 256 + (n0 & 127)) * D; }
            else if (type == 1) { W = in.w_up + (size_t)e * D * D; dst = WGU + ((size_t)e * 2048 + (n0 >> 7) * 256 + 128 + (n0 & 127)) * D; }
            else { W = in.w_down + (size_t)e * D * D; dst = WDN + ((size_t)e * D + n0) * D; }
            tr_item8(W, D, kb * 64, n0, dst, D, scr, lane);
        }
    }
    if (ph & (1u << PH_SMALLW)) {
        __syncthreads();
        for (int it = bx; it < 192; it += G) ada_item(in, mod, it, lds, tid);
        LAS float* scr = (LAS float*)(lds + wave * 16384);
        constexpr int I_IN = 16 * 81, I_OUT = 16 * 32;
        for (int it = gw; it < I_IN + I_OUT; it += NGW) {
            if (it < I_IN) { const int kb = it / 81, nb = it % 81, n0 = nb * 32; tr_item(in.w_in, DIN, kb * 64, n0, (DIN - n0) < 32 ? (DIN - n0) : 32, WtIn + (size_t)n0 * D, D, scr, lane); }
            else { const int r = it - I_IN, kb = r / 32, nb = r % 32; tr_item(in.w_out, D, kb * 64, nb * 32, 32, WtOut + (size_t)(nb * 32) * D, D, scr, lane); }
        }
        for (int i = bx * NTHR + tid; i < (NIN - DIN) * D / 8; i += G * NTHR) *(u32x4*)(WtIn + (size_t)DIN * D + (size_t)i * 8) = (u32x4){0u, 0u, 0u, 0u};
        for (int i = bx * NTHR + tid; i < 2 * 2 * 8 * 64 * 64; i += G * NTHR) {
            const int c = i & 63, o = (i >> 6) & 63, blk = (i >> 12) & 7, gsel = (i >> 15) & 1, d = i >> 16;
            const float* src = gsel ? in.lru_wx : in.lru_wa;
            WtL[i] = f2bf(-1.4426950408889634f * src[((size_t)(d * 8 + blk) * 64 + c) * 64 + o]); }
        for (int i = bx * NTHR + tid; i < NE * D; i += G * NTHR) { const int k = i >> 5, e = i & 31; const float w = in.w_router[i]; const bf16 hi = f2bf(w);
            bf16* wr = (bf16*)(ws + WS_WR); wr[e * RT_WP + k] = hi; wr[(NE + e) * RT_WP + k] = f2bf(w - bf2f(hi)); }
    }
    if (ph & 3u) PHASE_END(PH_WEXP);
    if (ph & (1u << PH_MOD)) {
        for (int r0 = gw * 4; r0 < T; r0 += NGW * 4) mod_rows<4>(in.x + (size_t)r0 * D, mod + (r0 / SEQ) * 6144, U + (size_t)r0 * D, lane);
        for (int r0 = gw; r0 < TC; r0 += NGW) mod_rows<1>(in.ctx + (size_t)r0 * D, mod + 4 * 6144, U + (size_t)(T + r0) * D, lane);
        PHASE_END(PH_MOD);
    }
    if (ph & (1u << PH_INPROJ)) {
        pg8::Gemm g{U, WtIn, D * 2}; pg8::StaticOrder S; S.init(MR, NIN, D * 2, G, bx);
        pg8::EpiInProj E{P, alow};
        pg8::gemm_phase<pg8::EpiInProj, pg8::StaticOrder, true, false>(lds, g, S, E);
        PHASE_END(PH_INPROJ);
    }
    if (ph & (1u << PH_MIX1)) {
#ifndef MK_REP
#define MK_REP 0
#endif
        for (int rep = 0; rep < ((MK_REP & 1) ? 2 : 1); ++rep)
        { constexpr int NU1 = BATCH * HEADS * 68;
          GlaPre cur, nxt;
          if (vcu < NU1) gla_fetch_pre(cur, in, alow, (vcu / 68) >> 2, (vcu / 68) & 3, vcu % 68, tid);
          for (int u = vcu; u < NU1; u += G) { const int n = u % 68, bh = u / 68, un = u + G;
              if (un < NU1) gla_fetch_pre(nxt, in, alow, (un / 68) >> 2, (un / 68) & 3, un % 68, tid);
              gla_pass1(in, cur, P, bh >> 2, bh & 3, n, lds, tid, kvbuf, decbuf);
              cur = nxt; } }
        for (int rep = 0; rep < ((MK_REP & 2) ? 2 : 1); ++rep)
        if (G == 256) {
            lru_unit<false>(in, P, WtL, gw >> 3, gw & 7, lds + wave * LRU_WAVE_LDS, lane, agg, carry, Y);
            const int u2 = 2048 + (vcu - 64);
            if (vcu >= 64 && wave == 0 && u2 < 272 * 8) lru_unit<false>(in, P, WtL, u2 >> 3, u2 & 7, lds + wave * LRU_WAVE_LDS, lane, agg, carry, Y);
        } else for (int u = gw; u < 272 * 8; u += NGW) lru_unit<false>(in, P, WtL, u >> 3, u & 7, lds + wave * LRU_WAVE_LDS, lane, agg, carry, Y);
        PHASE_END(PH_MIX1);
    }
    if (ph & (1u << PH_MIX2)) {
        { const int gid = bx * NTHR + tid;
          const int combo = gid >> 12, pr = gid & 4095, dv = pr >> 5, dk = (pr & 31) * 2, d = combo & 1, bh = combo >> 1;
          const bool hasG = combo < BATCH * HEADS * 2;
          const int nlw = (BATCH * 2 * DLRU) / 64;
          const bool hasL = (wave == 0) && (G >= nlw ? bx < nlw : true);
          f32x2 S = (f32x2){0.f, 0.f}; float h = 0.f;
          const bf16* kvp = kvbuf + (((size_t)bh * 68 * 2 + d) * DV + dv) * DK + dk; const float* dcp = decbuf + ((size_t)bh * 68 * 2 + d) * 64 + dk;
          bf16* sp = Sbuf + ((((size_t)bh * 64) * 2 + d) * DV + dv) * DK + dk;
          for (int lp = bx; lp < nlw; lp += G) {
              const int lg = lp * 64 + lane, ch = lg & 511, dL = (lg >> 9) & 1, bL = lg >> 10; const bool first = (lp == bx);
              if (!first) { S = (f32x2){0.f, 0.f}; }
              h = 0.f;
#pragma unroll 1
              for (int s0 = 0; s0 < 68; s0 += 17) { f32x2 kvv[17], dcv[17]; float av[17], bv[17];
                  if (hasG && first) {
#pragma unroll
                      for (int j = 0; j < 17; ++j) { const int st = s0 + j, n = d == 0 ? st : (st < 4 ? 3 - st : 71 - st); { const unsigned kvr = *(const unsigned*)(kvp + (size_t)n * (2 * DV * DK)); kvv[j] = (f32x2){__uint_as_float(kvr << 16), __uint_as_float(kvr & 0xffff0000u)}; } dcv[j] = *(const f32x2*)(dcp + n * 128); } }
                  if (hasL) {
#pragma unroll
                      for (int j = 0; j < 17; ++j) { const int st = s0 + j; int line; if (st < 4) line = 256 + bL * 4 + (dL == 0 ? st : 3 - st); else line = bL * 64 + (dL == 0 ? st - 4 : 67 - st);
                          const float* ag = agg + ((size_t)line * 2 + dL) * 2 * DLRU + ch; av[j] = ag[0]; bv[j] = ag[DLRU]; } }
                  if (hasG && first) {
#pragma unroll
                      for (int j = 0; j < 17; ++j) { const int st = s0 + j, n = d == 0 ? st : (st < 4 ? 3 - st : 71 - st);
                          if (n >= 4) *(unsigned*)(sp + (size_t)(n - 4) * (2 * DV * DK)) = pk2(S.x, S.y);
                          S = dcv[j] * S + kvv[j]; } }
                  if (hasL) {
#pragma unroll
                      for (int j = 0; j < 17; ++j) { const int st = s0 + j; int line; if (st < 4) line = 256 + bL * 4 + (dL == 0 ? st : 3 - st); else line = bL * 64 + (dL == 0 ? st - 4 : 67 - st);
                          if (line < 256) carry[((size_t)line * 2 + dL) * DLRU + ch] = h;
                          h = av[j] * h + bv[j]; asm volatile("" : "+v"(h)); } } } }
          if (bx >= nlw && hasG) {
#pragma unroll 1
              for (int s0 = 0; s0 < 68; s0 += 17) { f32x2 kvv[17], dcv[17];
#pragma unroll
                  for (int j = 0; j < 17; ++j) { const int st = s0 + j, n = d == 0 ? st : (st < 4 ? 3 - st : 71 - st); { const unsigned kvr = *(const unsigned*)(kvp + (size_t)n * (2 * DV * DK)); kvv[j] = (f32x2){__uint_as_float(kvr << 16), __uint_as_float(kvr & 0xffff0000u)}; } dcv[j] = *(const f32x2*)(dcp + n * 128); }
#pragma unroll
                  for (int j = 0; j < 17; ++j) { const int st = s0 + j, n = d == 0 ? st : (st < 4 ? 3 - st : 71 - st);
                      if (n >= 4) *(unsigned*)(sp + (size_t)(n - 4) * (2 * DV * DK)) = pk2(S.x, S.y);
                      S = dcv[j] * S + kvv[j]; } } } }
        PHASE_END(PH_MIX2);
    }
    if (ph & (1u << PH_MIX3)) {
        for (int rep = 0; rep < ((MK_REP & 4) ? 2 : 1); ++rep)
        for (int rep = 0; rep < ((MK_REP & 8) ? 2 : 1); ++rep)
        for (int u = gw; u < 256 * 8; u += NGW) lru_unit<true>(in, P, WtL, u >> 3, u & 7, lds + wave * LRU_WAVE_LDS, lane, agg, carry, Y);
        __syncthreads();
        { constexpr int NU = BATCH * HEADS * 64;
          GlaPre cur, nxt;
          if (vcu < NU) gla_fetch_pre(cur, in, alow, (vcu >> 6) >> 2, (vcu >> 6) & 3, (vcu & 63) + 4, tid);
          for (int u = vcu; u < NU; u += G) { const int c = u & 63, bh = u >> 6, un = u + G;
              if (un < NU) gla_fetch_pre(nxt, in, alow, (un >> 6) >> 2, (un >> 6) & 3, (un & 63) + 4, tid);
              gla_final(in, cur, P, bh >> 2, bh & 3, c, lds, tid, Sbuf, Y);
              cur = nxt; } }
        PHASE_END(PH_MIX3);
    }
    if (ph & (1u << PH_OUTPROJ)) {
        pg8::Gemm g{Y, WtOut, D * 2}; pg8::StaticOrder S; S.init(T, D, D * 2, G, bx);
        pg8::EpiOutProj E{in.x, mod, (bf16*)(ws + WS_Z)};
        pg8::gemm_phase<pg8::EpiOutProj, pg8::StaticOrder, true, false>(lds, g, S, E);
        PHASE_END(PH_OUTPROJ);
    }
    if (ph & (1u << PH_ROUTE)) {
        route_stage_w(ws + WS_WR, lds, tid);
        __syncthreads();
        for (int tile = vcu; tile < T / 64; tile += G) route_tile(in, (const bf16*)(ws + WS_Z), mod, H, (float*)(ws + WS_ROUTE_W), (int*)(ws + WS_CTL), (int*)(ws + WS_LIST), tile, lds, tid);
        PHASE_END(PH_ROUTE);
    }
    LAS int* utab = (LAS int*)(lds + LDSTBL_OFF + 320); LAS int* nuL = utab + 4 * MAXU_GU;
    if (ph & ((1u << PH_GU) | (1u << PH_DOWN))) {
        if (tid < 64) {
            const int c = lane < NE ? cnt[lane] : 0; int incl = (c + 127) >> 7;
#pragma unroll
            for (int o = 1; o < 32; o <<= 1) { const int t = __shfl_up(incl, o); if ((lane & 31) >= o) incl += t; }
            if (lane < NE) { cntl[lane] = c; tb[lane] = incl - ((c + 127) >> 7); if (lane == NE - 1) tb[NE] = incl; }
        }
        __syncthreads();
    }
    if (ph & (1u << PH_GU)) {
        LAS unsigned* tok = (LAS unsigned*)(lds + LDSTOK_OFF);
        pg8::moe_unit_table(tb, utab, nuL, 8, G, bx, MAXU_GU, tid);
        __syncthreads();
        pg8::MoeOrder8 S{utab, tok, nuL[0], D, 1};
        for (int idx = tid; idx < S.nu * 128; idx += NTHR) { const int i = idx >> 7, r = idx & 127, e = utab[4 * i + 2]; const int slot = (utab[4 * i] - tb[e]) * 128 + r;
            tok[idx] = slot < cntl[e] ? (unsigned)(list[(size_t)e * T + slot] >> 2) * (unsigned)D : 0u; }
        __syncthreads();
        pg8::Gemm g{H, WGU, D};
        pg8::EpiGU8 E{in.b_gate, in.b_up, ACT};
        pg8::gemm_phase8<pg8::EpiGU8>(lds, g, S, E);
        PHASE_END(PH_GU);
    }
    if (ph & (1u << PH_DOWN)) {
        LAS int* dtab = (LAS int*)(lds + LDSTOK_OFF); LAS float* wtab = (LAS float*)(lds + LDSTOK_OFF + MAXU_DN * 512);
        pg8::moe_unit_table(tb, utab, nuL, 4, G, bx, MAXU_DN, tid);
        __syncthreads();
        pg8::MoeOrder8 S{utab, nullptr, nuL[0], D, 0};
        for (int idx = tid; idx < S.nu * 128; idx += NTHR) { const int i = idx >> 7, r = idx & 127, e = utab[4 * i + 2]; const int slot = (utab[4 * i] - tb[e]) * 128 + r; int dest = -1; float wg = 0.f;
            if (slot < cntl[e]) { dest = list[(size_t)e * T + slot]; wg = tok_w[dest]; } dtab[idx] = dest; wtab[idx] = wg; }
        __syncthreads();
        pg8::Gemm g{ACT, WDN, D};
        pg8::EpiDown8 E{in.b_down, YBUF, dtab, wtab};
        pg8::gemm_phase8<pg8::EpiDown8>(lds, g, S, E);
        PHASE_END(PH_DOWN);
    }
    if (ph & (1u << PH_FINAL)) { if (gw < T) final_rows(in, (const bf16*)(ws + WS_Z), args.out, mod, YBUF, gw, NGW, lane); }
#undef PHASE_END
}

static int g_grid = 0;
static void launch_mega(const Args& a0, unsigned phases, hipStream_t stream) {
    Args a = a0; a.phases = phases;
    hipLaunchKernelGGL(mega, dim3(g_grid), dim3(NTHR), LDS_BYTES, stream, a);
}

extern "C" void kernel_launch(void* const* d_in, const int* in_sizes, int n_in, void* d_out, int out_size, void* d_ws, size_t ws_size, hipStream_t stream) {
    if (n_in != 30 || ws_size < WS_END) { fprintf(stderr, "kernel_launch: unexpected n_in %d or ws_size %zu (< %zu)\n", n_in, ws_size, (size_t)WS_END); return; }
    if (g_grid == 0) {
        int dev = 0, cus = 0, per_cu = 0;
        if (hipGetDevice(&dev) != hipSuccess || hipDeviceGetAttribute(&cus, hipDeviceAttributeMultiprocessorCount, dev) != hipSuccess) { fprintf(stderr, "kernel_launch: device query failed\n"); g_grid = -1; return; }
        if (hipFuncSetAttribute((const void*)mega, hipFuncAttributeMaxDynamicSharedMemorySize, LDS_BYTES) != hipSuccess) { fprintf(stderr, "kernel_launch: hipFuncSetAttribute failed\n"); g_grid = -1; return; }
        if (hipOccupancyMaxActiveBlocksPerMultiprocessor(&per_cu, (const void*)mega, NTHR, LDS_BYTES) != hipSuccess || per_cu < 1) { fprintf(stderr, "kernel_launch: occupancy query says %d blocks/CU\n", per_cu); g_grid = -1; return; }
        (void)hipGetLastError();
        g_grid = cus;
    }
    if (g_grid < 0) return;
    Args a{};
    const float** ip = (const float**)&a.in;
    for (int i = 0; i < 30; ++i) ip[i] = (const float*)d_in[i];
    a.out = (float*)d_out; a.ws = (unsigned char*)d_ws;
    unsigned char* ws = (unsigned char*)d_ws;
    (void)hipMemsetAsync(ws + WS_CTL, 0, CTL_ZERO_BYTES, stream);
#ifndef MK_PER_PHASE
#define MK_PER_PHASE 0
#endif
    const unsigned all = (1u << PH_SMALLW) | (1u << PH_WEXP) | (1u << PH_MOD) | (1u << PH_INPROJ) | (1u << PH_MIX1) | (1u << PH_MIX2) | (1u << PH_MIX3) | (1u << PH_OUTPROJ) | (1u << PH_ROUTE) | (1u << PH_GU) | (1u << PH_DOWN) | (1u << PH_FINAL);
#ifndef MK_DUP_MASK
#define MK_DUP_MASK 0u
#endif
    if (MK_PER_PHASE) { for (int p = 0; p < 12; ++p) if (all & (1u << p)) { launch_mega(a, 1u << p, stream); if (MK_DUP_MASK & (1u << p)) { if (p == PH_ROUTE) (void)hipMemsetAsync(ws + WS_CTL, 0, 4096, stream); launch_mega(a, 1u << p, stream); } } }
    else launch_mega(a, all, stream);
}
```
